# Optimizing an MI355X kernel written in HIP

```python
import math
import jax, jax.numpy as jnp
from jax import lax
import numpy as np

D_MODEL = 1024
BATCH = 2
SEQ = 8192
DEPTH = 4

PLE_DIM = 256
SB_HEADS = 8
SB_HEAD_DIM = 64
SB_WIDTH = SB_HEADS * SB_HEAD_DIM
RW_HEADS = 8
RW_HEAD_DIM = 64
RW_WIDTH = RW_HEADS * RW_HEAD_DIM
RW_DECAY_LORA = 64
RW_AAA_LORA = 64
RW_GATE_LORA = 160
RW_GN_EPS = 64e-5
RW_IN = 3 * RW_WIDTH + RW_DECAY_LORA + RW_AAA_LORA + RW_GATE_LORA
HYB_IN = 3 * SB_WIDTH + RW_IN
HYB_OUT = SB_WIDTH + RW_WIDTH
MLA_HEADS = 16
MLA_NOPE = 64
MLA_ROPE = 32
MLA_V = 64
MLA_Q_RANK = 384
MLA_KV_RANK = 256
MLA_DOWN = MLA_Q_RANK + MLA_KV_RANK + MLA_ROPE
ROPE_THETA = 10000.0
FFN_DIM = 2816
CONV_WIDTH = 3
Q_BLOCK = 128
NORM_EPS = 1e-6
N_EVEN = (DEPTH + 1) // 2
N_ODD = DEPTH // 2

kernel_name = "hybrid_sb_rwkv7_mla_convglu"

F32 = jnp.float32


def rmsnorm(x, g):
    xf = x.astype(F32)
    y = xf * lax.rsqrt(jnp.mean(xf * xf, axis=-1, keepdims=True) + NORM_EPS)
    return (y * g.astype(F32)).astype(x.dtype)


def shift_right(x, n):
    return jnp.pad(x, ((0, 0), (n, 0), (0, 0)))[:, : x.shape[1]]


def sweep_query_blocks(fn, q):
    b, s, h, e = q.shape
    nb = s // Q_BLOCK
    qb = q.reshape(b, nb, Q_BLOCK, h, e).transpose(1, 0, 2, 3, 4)
    starts = jnp.arange(nb, dtype=jnp.int32) * Q_BLOCK
    out = lax.map(lambda args: fn(args[0], args[1]), (qb, starts))
    return out.transpose(1, 0, 2, 3, 4).reshape(b, s, h, out.shape[-1])


def stick_breaking_attention(q, k, v):
    s_len = k.shape[1]
    scale = 1.0 / math.sqrt(q.shape[-1])
    key_pos = jnp.arange(s_len, dtype=jnp.int32)
    kf = k.astype(F32)
    vf = v.astype(F32)

    def block(qb, t0):
        z = jnp.einsum('bqhe,bshe->bhqs', qb.astype(F32), kf) * scale
        qpos = t0 + jnp.arange(Q_BLOCK, dtype=jnp.int32)
        mask = key_pos[None, :] < qpos[:, None]
        log_one_minus = jnp.where(mask, -jax.nn.softplus(z), 0.0)
        rev = lax.cumsum(log_one_minus, axis=3, reverse=True)
        after = jnp.concatenate([rev[..., 1:], jnp.zeros_like(rev[..., :1])], axis=3)
        w = jnp.where(mask, jnp.exp(jax.nn.log_sigmoid(z) + after), 0.0)
        return jnp.einsum('bhqs,bshe->bqhe', w, vf)

    return sweep_query_blocks(block, q).astype(v.dtype)


def causal_softmax_attention(q, k, v, scale):
    s_len = k.shape[1]
    key_pos = jnp.arange(s_len, dtype=jnp.int32)
    kf = k.astype(F32)
    vf = v.astype(F32)

    def block(qb, t0):
        sc = jnp.einsum('bqhe,bshe->bhqs', qb.astype(F32), kf) * scale
        qpos = t0 + jnp.arange(Q_BLOCK, dtype=jnp.int32)
        mask = key_pos[None, :] <= qpos[:, None]
        w = jax.nn.softmax(jnp.where(mask, sc, -jnp.inf), axis=-1)
        return jnp.einsum('bhqs,bshe->bqhe', w, vf)

    return sweep_query_blocks(block, q).astype(v.dtype)


def apply_rope(x, positions):
    half = x.shape[-1] // 2
    inv_freq = ROPE_THETA ** (-jnp.arange(half, dtype=F32) / half)
    ang = positions.astype(F32)[:, :, None, None] * inv_freq
    cos, sin = jnp.cos(ang), jnp.sin(ang)
    xf = x.astype(F32)
    x1, x2 = xf[..., :half], xf[..., half:]
    return jnp.concatenate([x1 * cos - x2 * sin, x1 * sin + x2 * cos], axis=-1).astype(x.dtype)


def rwkv7_time_mix(proj, mu, w0, w2, a0, a2, g2, k_k, k_a, r_k, ln_w, ln_b):
    b, s, _ = proj.shape
    pf = proj.astype(F32)
    xm = pf + (shift_right(pf, 1) - pf) * mu
    r, k, v, wl, al, gl = jnp.split(
        xm, [RW_WIDTH, 2 * RW_WIDTH, 3 * RW_WIDTH, 3 * RW_WIDTH + RW_DECAY_LORA,
             3 * RW_WIDTH + RW_DECAY_LORA + RW_AAA_LORA], axis=-1)
    w = -jax.nn.softplus(-(w0 + jnp.tanh(wl) @ w2)) - 0.5
    decay = jnp.exp(-jnp.exp(w))
    a = jax.nn.sigmoid(a0 + al @ a2)
    g = jax.nn.sigmoid(gl) @ g2

    hd = lambda t: t.reshape(b, s, RW_HEADS, RW_HEAD_DIM)
    ph = lambda t: t.astype(F32).reshape(RW_HEADS, RW_HEAD_DIM)
    r, k, v, decay, a = hd(r), hd(k), hd(v), hd(decay), hd(a)
    kk = k * ph(k_k)
    kk = kk * lax.rsqrt(jnp.maximum(jnp.sum(kk * kk, axis=-1, keepdims=True), 1e-24))
    k = k * (1.0 + (a - 1.0) * ph(k_a))

    def step(state, inp):
        r_t, w_t, k_t, v_t, kk_t, a_t = inp
        sa = jnp.einsum('bhij,bhj->bhi', state, -kk_t)
        state = (state * w_t[:, :, None, :] + sa[..., None] * (kk_t * a_t)[:, :, None, :]
                 + v_t[..., None] * k_t[:, :, None, :])
        return state, jnp.einsum('bhij,bhj->bhi', state, r_t)

    tm = lambda t: jnp.moveaxis(t, 1, 0)
    state0 = jnp.zeros((b, RW_HEADS, RW_HEAD_DIM, RW_HEAD_DIM), F32)
    _, y = lax.scan(step, state0, (tm(r), tm(decay), tm(k), tm(v), tm(kk), tm(a)))
    y = jnp.moveaxis(y, 0, 1)

    mean = jnp.mean(y, axis=-1, keepdims=True)
    var = jnp.mean(jnp.square(y - mean), axis=-1, keepdims=True)
    y = (y - mean) * lax.rsqrt(var + RW_GN_EPS)
    y = y * ph(ln_w) + ph(ln_b)
    y = y + jnp.sum(r * k * r_k.astype(F32), axis=-1, keepdims=True) * v
    return (y.reshape(b, s, RW_WIDTH) * g).astype(proj.dtype)


def sb_rwkv_mixer(hn, w_in, w_out, mu, w0, w2, a0, a2, g2, k_k, k_a, r_k, ln_w, ln_b):
    b, s, _ = hn.shape
    proj = hn @ w_in
    qa, ka, va, rw = jnp.split(proj, [SB_WIDTH, 2 * SB_WIDTH, 3 * SB_WIDTH], axis=-1)
    hd = lambda t: t.reshape(b, s, SB_HEADS, SB_HEAD_DIM)
    o_a = stick_breaking_attention(hd(qa), hd(ka), hd(va)).reshape(b, s, SB_WIDTH)
    o_b = rwkv7_time_mix(rw, mu, w0, w2, a0, a2, g2, k_k, k_a, r_k, ln_w, ln_b)
    return jnp.concatenate([o_a, o_b.astype(o_a.dtype)], axis=-1) @ w_out


def mla_mixer(hn, positions, w_down, q_norm, kv_norm, w_uq, w_ukv, w_o):
    b, s, _ = hn.shape
    c = hn @ w_down
    cq, ckv, kr = jnp.split(c, [MLA_Q_RANK, MLA_Q_RANK + MLA_KV_RANK], axis=-1)
    q = (rmsnorm(cq, q_norm) @ w_uq).reshape(b, s, MLA_HEADS, MLA_NOPE + MLA_ROPE)
    kv = (rmsnorm(ckv, kv_norm) @ w_ukv).reshape(b, s, MLA_HEADS, MLA_NOPE + MLA_V)
    q_nope, q_rope = jnp.split(q, [MLA_NOPE], axis=-1)
    k_nope, v = jnp.split(kv, [MLA_NOPE], axis=-1)
    q = jnp.concatenate([q_nope, apply_rope(q_rope, positions)], axis=-1)
    k_rope = jnp.broadcast_to(apply_rope(kr[:, :, None, :], positions), (b, s, MLA_HEADS, MLA_ROPE))
    k = jnp.concatenate([k_nope, k_rope], axis=-1)
    o = causal_softmax_attention(q, k, v, 1.0 / math.sqrt(MLA_NOPE + MLA_ROPE))
    return o.reshape(b, s, MLA_HEADS * MLA_V) @ w_o


def conv_glu(hn, w_in, conv_w, conv_b, w_out):
    u, gate_in = jnp.split(hn @ w_in, 2, axis=-1)
    c = (conv_w[0] * shift_right(gate_in, 2) + conv_w[1] * shift_right(gate_in, 1)
         + conv_w[2] * gate_in + conv_b)
    return (jax.nn.gelu(c, approximate=False) * u) @ w_out


def setup_inputs(seed: int = 0) -> dict:
    key = jax.random.key(seed)
    keys = jax.random.split(key, 48)
    counter = [0]

    def nk():
        kk = keys[counter[0]]
        counter[0] += 1
        return kk

    def nrm(shape, scale):
        return jax.random.normal(nk(), shape, F32) * scale

    def gain(shape):
        return 1.0 + nrm(shape, 0.05)

    x = nrm((BATCH, SEQ, D_MODEL), 1.0)
    p = nrm((DEPTH, BATCH, SEQ, PLE_DIM), 1.0)
    offset = jax.random.randint(nk(), (BATCH, 1), 0, 4096, dtype=jnp.int32)
    positions = offset + jnp.arange(SEQ, dtype=jnp.int32)[None, :]
    return {
        "x": x,
        "p": p,
        "positions": positions,
        "attn_norm": gain((DEPTH, D_MODEL)),
        "ffn_norm": gain((DEPTH, D_MODEL)),
        "ffn_w_in": nrm((DEPTH, D_MODEL, 2 * FFN_DIM), D_MODEL ** -0.5),
        "ffn_conv_w": nrm((DEPTH, CONV_WIDTH, FFN_DIM), CONV_WIDTH ** -0.5),
        "ffn_conv_b": nrm((DEPTH, FFN_DIM), 0.01),
        "ffn_w_out": nrm((DEPTH, FFN_DIM, D_MODEL), FFN_DIM ** -0.5),
        "ple_w_proj": nrm((DEPTH, PLE_DIM, D_MODEL), PLE_DIM ** -0.5),
        "ple_norm": gain((DEPTH, D_MODEL)),
        "ple_gate_norm": gain((DEPTH, D_MODEL)),
        "ple_w_gate": nrm((DEPTH, D_MODEL, D_MODEL), D_MODEL ** -0.5),
        "hyb_w_in": nrm((N_EVEN, D_MODEL, HYB_IN), D_MODEL ** -0.5),
        "hyb_w_out": nrm((N_EVEN, HYB_OUT, D_MODEL), HYB_OUT ** -0.5),
        "rw_mu": jax.random.uniform(nk(), (N_EVEN, RW_IN), F32),
        "rw_w0": jax.random.uniform(nk(), (N_EVEN, RW_WIDTH), F32, -6.0, 1.0),
        "rw_w2": nrm((N_EVEN, RW_DECAY_LORA, RW_WIDTH), RW_DECAY_LORA ** -0.5),
        "rw_a0": nrm((N_EVEN, RW_WIDTH), 0.1),
        "rw_a2": nrm((N_EVEN, RW_AAA_LORA, RW_WIDTH), RW_AAA_LORA ** -0.5),
        "rw_g2": nrm((N_EVEN, RW_GATE_LORA, RW_WIDTH), RW_GATE_LORA ** -0.5),
        "rw_k_k": 0.85 + nrm((N_EVEN, RW_WIDTH), 0.05),
        "rw_k_a": gain((N_EVEN, RW_WIDTH)),
        "rw_r_k": nrm((N_EVEN, RW_HEADS, RW_HEAD_DIM), 0.1),
        "rw_ln_w": gain((N_EVEN, RW_WIDTH)),
        "rw_ln_b": nrm((N_EVEN, RW_WIDTH), 0.01),
        "mla_w_down": nrm((N_ODD, D_MODEL, MLA_DOWN), D_MODEL ** -0.5),
        "mla_q_norm": gain((N_ODD, MLA_Q_RANK)),
        "mla_kv_norm": gain((N_ODD, MLA_KV_RANK)),
        "mla_w_uq": nrm((N_ODD, MLA_Q_RANK, MLA_HEADS * (MLA_NOPE + MLA_ROPE)), MLA_Q_RANK ** -0.5),
        "mla_w_ukv": nrm((N_ODD, MLA_KV_RANK, MLA_HEADS * (MLA_NOPE + MLA_V)), MLA_KV_RANK ** -0.5),
        "mla_w_o": nrm((N_ODD, MLA_HEADS * MLA_V, D_MODEL), (MLA_HEADS * MLA_V) ** -0.5),
        "final_norm": gain((D_MODEL,)),
    }


def reference(x, p, positions, attn_norm, ffn_norm, ffn_w_in, ffn_conv_w, ffn_conv_b, ffn_w_out,
              ple_w_proj, ple_norm, ple_gate_norm, ple_w_gate,
              hyb_w_in, hyb_w_out, rw_mu, rw_w0, rw_w2, rw_a0, rw_a2, rw_g2, rw_k_k, rw_k_a,
              rw_r_k, rw_ln_w, rw_ln_b,
              mla_w_down, mla_q_norm, mla_kv_norm, mla_w_uq, mla_w_ukv, mla_w_o, final_norm):
    h = x
    for i in range(DEPTH):
        j = i // 2
        hn = rmsnorm(h, attn_norm[i])
        if i % 2 == 0:
            mix = sb_rwkv_mixer(hn, hyb_w_in[j], hyb_w_out[j], rw_mu[j], rw_w0[j], rw_w2[j],
                                rw_a0[j], rw_a2[j], rw_g2[j], rw_k_k[j], rw_k_a[j], rw_r_k[j],
                                rw_ln_w[j], rw_ln_b[j])
        else:
            mix = mla_mixer(hn, positions, mla_w_down[j], mla_q_norm[j], mla_kv_norm[j],
                            mla_w_uq[j], mla_w_ukv[j], mla_w_o[j])
        h = h + mix
        h = h + conv_glu(rmsnorm(h, ffn_norm[i]), ffn_w_in[i], ffn_conv_w[i], ffn_conv_b[i], ffn_w_out[i])
        e = rmsnorm(p[i] @ ple_w_proj[i], ple_norm[i])
        gate = jax.nn.sigmoid(rmsnorm(h, ple_gate_norm[i]) @ ple_w_gate[i])
        h = h + gate * e
    return rmsnorm(h, final_norm)
```

```cpp
#include <hip/hip_runtime.h>
#include <hip/hip_cooperative_groups.h>
#include <cstdio>
#include <cstdint>
namespace cg = cooperative_groups;
namespace pg8 {
#define PG8_LAS __attribute__((address_space(3)))
typedef unsigned short bf16_t;
typedef short bf16x8 __attribute__((ext_vector_type(8)));
typedef float f32x4 __attribute__((ext_vector_type(4)));
typedef unsigned u32x4 __attribute__((ext_vector_type(4)));
constexpr int BM = 256, BK = 64, HALF = 128, HTB = HALF * BK * 2  , STAGE_BYTES = 8 * HTB, NXCD = 8, WGM = 8;

__host__ __device__ __forceinline__ int lds_byte(int r, int c) { const int st = (r >> 4) * 2 + (c >> 5), rr = r & 15, cc = c & 31, ob = rr * 64 + cc * 2; return st * 1024 + (ob ^ (((ob >> 9) & 1) << 5)); }
__host__ __device__ __forceinline__ void stage_rc(int b, int& R, int& C) { const int st = b / 1024, sb = b % 1024, swz = sb ^ (((sb >> 9) & 1) << 5); R = (st >> 1) * 16 + swz / 64; C = (st & 1) * 32 + (swz % 64) / 2; }
__host__ __device__ __forceinline__ int perm32(int rho) { const int n = rho >> 4, i = rho & 15; return 8 * (i >> 2) + 4 * n + (i & 3); }

struct Unit { int pm, pn; };
struct Gemm { const bf16_t* A; const bf16_t* Bt; int M, N, K; };

struct StaticOrder {
    int nM, nN, nwg, G, c;
    __host__ __device__ void init(int M, int N, int G_, int c_) { nM = M / BM; nN = N / BM; nwg = nM * nN; G = G_; c = c_; }
    __host__ __device__ bool next(int i, Unit& u) const {
        const long L = (long)i * G + c; if (L >= nwg) return false;
        int wgid = (int)L; { const int q = nwg / NXCD, r = nwg % NXCD, xcd = wgid % NXCD, off = wgid / NXCD; wgid = (xcd < r ? xcd * (q + 1) : r * (q + 1) + (xcd - r) * q) + off; }
        const int nig = WGM * nN, gid = wgid / nig, fm = gid * WGM, gsz = (nM - fm) < WGM ? (nM - fm) : WGM;
        u.pm = fm + ((wgid % nig) % gsz); u.pn = (wgid % nig) / gsz; return true;
    }
    __device__ __forceinline__ void a_ready(const Unit&) const {}
    __device__ __forceinline__ void done(const Unit&) const {}
};

__device__ __forceinline__ unsigned cvt_pk_bf16(float lo, float hi) { unsigned r; asm volatile("v_cvt_pk_bf16_f32 %0, %1, %2" : "=v"(r) : "v"(lo), "v"(hi)); return r; }
typedef float f32x2 __attribute__((ext_vector_type(2)));
__device__ __forceinline__ f32x2 gelu_pk(f32x2 v) {
    const f32x2 av = __builtin_elementwise_abs(v), d = av * 0.2316418882f + 1.0f;
    f32x2 t; t.x = __builtin_amdgcn_rcpf(d.x); t.y = __builtin_amdgcn_rcpf(d.y);
    f32x2 q = t * 0.5307027145f + (-0.7265760135f); q = q * t + 0.7107068705f; q = q * t + (-0.142248368f); q = q * t + 0.127414796f; q = q * t;
    const f32x2 s = (v * v) * (-0.72134752044f);
    f32x2 e; e.x = __builtin_amdgcn_exp2f(s.x); e.y = __builtin_amdgcn_exp2f(s.y);
    const f32x2 m = v * (q * e), r = v - m;
    f32x2 o; o.x = v.x < 0.f ? m.x : r.x; o.y = v.y < 0.f ? m.y : r.y; return o;
}
template <class Epi, class Sched, bool ALIGN_EPI = false, bool SP2 = false>
__device__ __forceinline__ void gemm_phase(PG8_LAS unsigned char* lds, const Gemm g, const Sched& S, const Epi& E) {
    const int tid = threadIdx.x, wid = __builtin_amdgcn_readfirstlane(tid >> 6), lane = tid & 63, wr = wid >> 2, wc = wid & 3, fr = lane & 15, fq = lane >> 4;
    const int K = g.K, nt = K / BK;
    unsigned voffA[2], voffB[2];
#pragma unroll
    for (int i = 0; i < 2; ++i) { int R, C; stage_rc(tid * 16 + i * 8192, R, C); const int Rb = Epi::PERM ? ((R & ~31) + perm32(R & 31)) : R;
        voffA[i] = (unsigned)(R * K + C) * 2u; voffB[i] = (unsigned)(Rb * K + C) * 2u; }
    const size_t kstep = (size_t)(BK * 2);
    const size_t hstep = (size_t)HALF * K * 2;
    const size_t tstep = 2 * hstep;
    const unsigned ldsw = (unsigned)wid * 1024u;
    const int aoff = lds_byte(wr * 64 + fr, fq * 8), boff = lds_byte(wc * 32 + fr, fq * 8);
#define PG8_SA(b, h) (((b) * 2 + (h)) * HTB)
#define PG8_SB(b, h) ((4 + (b) * 2 + (h)) * HTB)
#define PG8_STAGE(bufoff, gbase, voff) do { _Pragma("unroll") for (int _i = 0; _i < 2; ++_i) \
        __builtin_amdgcn_global_load_lds((const unsigned*)((const char*)(gbase) + (voff)[_i]), (PG8_LAS unsigned*)(lds + (bufoff) + ldsw + _i * 8192), 16, 0, 0); } while (0)
#define PG8_LDA(dst, b, h) do { _Pragma("unroll") for (int m = 0; m < 4; ++m) _Pragma("unroll") for (int k = 0; k < 2; ++k) dst[m][k] = *(const PG8_LAS bf16x8*)(lds + PG8_SA(b, h) + aoff + m * 2048 + k * 1024); } while (0)
#define PG8_LDB(dst, b, h) do { _Pragma("unroll") for (int n = 0; n < 2; ++n) _Pragma("unroll") for (int k = 0; k < 2; ++k) dst[n][k] = *(const PG8_LAS bf16x8*)(lds + PG8_SB(b, h) + boff + n * 2048 + k * 1024); } while (0)
#define PG8_MMA(ai, bj, At, Bt) do { __builtin_amdgcn_s_setprio(1); _Pragma("unroll") for (int m = 0; m < 4; ++m) _Pragma("unroll") for (int n = 0; n < 2; ++n) _Pragma("unroll") for (int k = 0; k < 2; ++k) \
        acc[ai][bj][m][n] = __builtin_amdgcn_mfma_f32_16x16x32_bf16(Bt[n][k], At[m][k], acc[ai][bj][m][n], 0, 0, 0); __builtin_amdgcn_s_setprio(0); } while (0)
#define PG8_WAIT_V(n) asm volatile("s_waitcnt vmcnt(" #n ")" ::: "memory")
#define PG8_WAIT_L(n) asm volatile("s_waitcnt lgkmcnt(" #n ")" ::: "memory")
#define PG8_BAR __builtin_amdgcn_s_barrier()
#define PG8_SCHED __builtin_amdgcn_sched_barrier(0)
    Unit cur, nxt; int ui = 0;
    if (!S.next(0, cur)) return;
    f32x4 acc[2][2][4][2];
#pragma unroll
    for (int a = 0; a < 2; ++a)
#pragma unroll
        for (int b = 0; b < 2; ++b)
#pragma unroll
            for (int m = 0; m < 4; ++m)
#pragma unroll
                for (int n = 0; n < 2; ++n) acc[a][b][m][n] = (f32x4){0.f, 0.f, 0.f, 0.f};
    bf16x8 At[4][2], B0[2][2], B1[2][2];
    const char* cA = (const char*)g.A + (size_t)cur.pm * tstep; const char* cB = (const char*)g.Bt + (size_t)cur.pn * tstep;
    S.a_ready(cur);
    if constexpr (SP2) {
        PG8_STAGE(PG8_SB(0, 0), cB, voffB); PG8_STAGE(PG8_SB(0, 1), cB + hstep, voffB); PG8_STAGE(PG8_SA(0, 0), cA, voffA); PG8_STAGE(PG8_SA(0, 1), cA + hstep, voffA);
        if (wr == 1) PG8_BAR;
        PG8_WAIT_V(2); PG8_BAR;
        PG8_STAGE(PG8_SB(1, 0), cB + kstep, voffB); PG8_STAGE(PG8_SA(1, 0), cA + kstep, voffA); PG8_STAGE(PG8_SB(1, 1), cB + hstep + kstep, voffB);
        PG8_WAIT_V(6); PG8_BAR;
    } else {
        PG8_STAGE(PG8_SB(0, 0), cB, voffB); PG8_STAGE(PG8_SA(0, 0), cA, voffA); PG8_STAGE(PG8_SB(0, 1), cB + hstep, voffB); PG8_STAGE(PG8_SA(0, 1), cA + hstep, voffA);
        if (wr == 1) PG8_BAR;
        PG8_WAIT_V(4); PG8_BAR;
        PG8_STAGE(PG8_SB(1, 0), cB + kstep, voffB); PG8_STAGE(PG8_SA(1, 0), cA + kstep, voffA); PG8_STAGE(PG8_SB(1, 1), cB + hstep + kstep, voffB);
        PG8_WAIT_V(6); PG8_BAR;
    }
    for (;;) {
        const bool has_next = S.next(ui + 1, nxt);
        const char* nA = has_next ? (const char*)g.A + (size_t)nxt.pm * tstep : cA; const char* nB = has_next ? (const char*)g.Bt + (size_t)nxt.pn * tstep : cB;
        for (int t = 0; t < nt; t += 2) {
            const bool last = (t == nt - 2);
            const char* a1 = cA + (size_t)(t + 1) * kstep;
            const char* a2 = last ? nA : cA + (size_t)(t + 2) * kstep; const char* b2 = last ? nB : cB + (size_t)(t + 2) * kstep;
            const char* a3 = a2 + kstep; const char* b3 = b2 + kstep;
            if (last && has_next) S.a_ready(nxt);
            if constexpr (SP2) {
            PG8_LDB(B0, 0, 0); PG8_LDB(B1, 0, 1); PG8_SCHED; PG8_LDA(At, 0, 0); PG8_STAGE(PG8_SA(1, 1), a1 + hstep, voffA);
            PG8_WAIT_V(8); PG8_WAIT_L(0); PG8_BAR; PG8_MMA(0, 0, At, B0); PG8_MMA(0, 1, At, B1); PG8_BAR; PG8_SCHED;
            PG8_LDA(At, 0, 1); PG8_STAGE(PG8_SB(0, 0), b2, voffB); PG8_STAGE(PG8_SB(0, 1), b2 + hstep, voffB); PG8_STAGE(PG8_SA(0, 0), a2, voffA);
            PG8_WAIT_V(8); PG8_WAIT_L(0); PG8_BAR; PG8_MMA(1, 0, At, B0); PG8_MMA(1, 1, At, B1); PG8_BAR; PG8_SCHED;
            PG8_LDB(B0, 1, 0); PG8_LDB(B1, 1, 1); PG8_SCHED; PG8_LDA(At, 1, 0); PG8_STAGE(PG8_SA(0, 1), a2 + hstep, voffA);
            PG8_WAIT_V(8); PG8_WAIT_L(0); PG8_BAR; PG8_MMA(0, 0, At, B0); PG8_MMA(0, 1, At, B1); PG8_BAR; PG8_SCHED;
            PG8_LDA(At, 1, 1); PG8_STAGE(PG8_SB(1, 0), b3, voffB); PG8_STAGE(PG8_SB(1, 1), b3 + hstep, voffB); PG8_STAGE(PG8_SA(1, 0), a3, voffA);
            PG8_WAIT_V(8); PG8_WAIT_L(0); PG8_BAR; PG8_MMA(1, 0, At, B0); PG8_MMA(1, 1, At, B1); PG8_BAR; PG8_SCHED;
            } else {
            PG8_LDB(B0, 0, 0); PG8_SCHED; PG8_LDA(At, 0, 0); PG8_STAGE(PG8_SA(1, 1), a1 + hstep, voffA);
            PG8_WAIT_L(8); PG8_BAR; PG8_WAIT_L(0); PG8_MMA(0, 0, At, B0); PG8_BAR; PG8_SCHED;
            PG8_LDB(B1, 0, 1); PG8_STAGE(PG8_SB(0, 0), b2, voffB);
            PG8_BAR; PG8_WAIT_L(0); PG8_MMA(0, 1, At, B1); PG8_BAR;
            PG8_LDA(At, 0, 1); PG8_STAGE(PG8_SA(0, 0), a2, voffA);
            PG8_BAR; PG8_WAIT_L(0); PG8_MMA(1, 0, At, B0); PG8_BAR; PG8_SCHED;
            PG8_STAGE(PG8_SB(0, 1), b2 + hstep, voffB);
            PG8_WAIT_V(6); PG8_BAR; PG8_MMA(1, 1, At, B1); PG8_BAR;
            PG8_LDB(B0, 1, 0); PG8_SCHED; PG8_LDA(At, 1, 0); PG8_STAGE(PG8_SA(0, 1), a2 + hstep, voffA);
            PG8_WAIT_L(8); PG8_BAR; PG8_WAIT_L(0); PG8_MMA(0, 0, At, B0); PG8_BAR; PG8_SCHED;
            PG8_LDB(B1, 1, 1); PG8_STAGE(PG8_SB(1, 0), b3, voffB);
            PG8_BAR; PG8_WAIT_L(0); PG8_MMA(0, 1, At, B1); PG8_BAR;
            PG8_LDA(At, 1, 1); PG8_STAGE(PG8_SA(1, 0), a3, voffA);
            PG8_BAR; PG8_WAIT_L(0); PG8_MMA(1, 0, At, B0); PG8_BAR; PG8_SCHED;
            PG8_STAGE(PG8_SB(1, 1), b3 + hstep, voffB);
            PG8_WAIT_V(6); PG8_BAR; PG8_MMA(1, 1, At, B1); PG8_BAR;
            }
        }
        if constexpr (ALIGN_EPI) { if (wr == 0) PG8_BAR; }
        if constexpr (!Epi::AFTER_DRAIN) { E(acc, cur, wr, wc, fr, fq); S.done(cur); }
        if (!has_next) break;
#pragma unroll
        for (int a = 0; a < 2; ++a)
#pragma unroll
            for (int b = 0; b < 2; ++b)
#pragma unroll
                for (int m = 0; m < 4; ++m)
#pragma unroll
                    for (int n = 0; n < 2; ++n) acc[a][b][m][n] = (f32x4){0.f, 0.f, 0.f, 0.f};
        cur = nxt; cA = nA; cB = nB; ++ui;
        if constexpr (ALIGN_EPI) { if (wr == 1) PG8_BAR; }
    }
    PG8_WAIT_V(0);
    if constexpr (!ALIGN_EPI) { if (wr == 0) PG8_BAR; }
    PG8_BAR;
    if constexpr (Epi::AFTER_DRAIN) { E.fused(acc, cur, wr, wc, fr, fq, lds, wid, lane); S.done(cur); }
#undef PG8_SA
#undef PG8_SB
#undef PG8_STAGE
#undef PG8_LDA
#undef PG8_LDB
#undef PG8_MMA
#undef PG8_WAIT_V
#undef PG8_WAIT_L
#undef PG8_BAR
#undef PG8_SCHED
}
}
#ifndef PH_GEMM
#define PH_GEMM 1
#endif

#define GAS __attribute__((address_space(1)))
#define LAS __attribute__((address_space(3)))
typedef unsigned short bf16;
typedef unsigned v4u __attribute__((ext_vector_type(4)));
typedef unsigned v2u __attribute__((ext_vector_type(2)));
typedef float f32x4 __attribute__((ext_vector_type(4)));
typedef float f32x2 __attribute__((ext_vector_type(2)));
typedef float f32x16 __attribute__((ext_vector_type(16)));
typedef short bf16x8 __attribute__((ext_vector_type(8)));
typedef short s16x4 __attribute__((ext_vector_type(4)));
#ifndef SCAN_SMEM
#define SCAN_SMEM 1
#endif
#if SCAN_SMEM
typedef __attribute__((address_space(4))) const float cfloat;
#else
typedef const float cfloat;
#endif
using pg8::Unit;
extern __shared__ __attribute__((aligned(16))) unsigned char g_lds[];
constexpr int PTAB_OFF = 131072;
__device__ __forceinline__ const float* ptr(int i) { const unsigned long long v = *(const volatile unsigned long long*)(g_lds + PTAB_OFF + 8 * i);
    const unsigned lo = __builtin_amdgcn_readfirstlane((unsigned)v), hi = __builtin_amdgcn_readfirstlane((unsigned)(v >> 32)); return (const float*)(GAS const float*)(((unsigned long long)hi << 32) | lo); }
#define P_H ((float*)ptr(33))
#define P_WS ((unsigned char*)ptr(34))

constexpr int T = 16384, SEQ = 8192, D = 1024, FFN = 2816;
constexpr int NCH = 64, CHL = SEQ / NCH;
constexpr float EPS = 1e-6f;
constexpr size_t MiB = 1u << 20;
constexpr size_t WS_RSS = 0, WS_ROPE = 2 * MiB, WS_HA = 4 * MiB, WS_W = 36 * MiB, WS_PB = 68 * MiB, WS_R = 76 * MiB, WS_NEED = 352 * MiB;
constexpr size_t W_HYBIN = 0, W_LORA = 7 * MiB, W_HYBOUT = 8 * MiB + 512 * 1024;
constexpr size_t W_DOWN = 0, W_UQ = 2 * MiB, W_UKV = 4 * MiB, W_WO = 6 * MiB;
constexpr size_t W_FFNIN = 12 * MiB, W_FFNOUT = 23 * MiB, W_PLEP = 28 * MiB + 512 * 1024, W_PLEG = 29 * MiB;
constexpr size_t R_QK = 0, R_VTSB = 32 * MiB, R_G = 80 * MiB  , R_RWP = 48 * MiB, R_PL = 48 * MiB, R_SCAN = 106 * MiB;
constexpr size_t R_GATE = 0, R_ACT = 88 * MiB, R_PE = 176 * MiB;
constexpr size_t R_CQ = 0, R_CKV = 12 * MiB, R_KROPE = 20 * MiB, R_Q = 24 * MiB, R_KN = 72 * MiB, R_VT = 104 * MiB, R_O = 136 * MiB;
constexpr size_t HA_VBF = 0, HA_ACAT = 16 * MiB;
constexpr size_t R_HA2 = 208 * MiB;
constexpr int RWP_LD = 1856;
constexpr size_t R_RSP = 266 * MiB; constexpr size_t RSP_BYTES = 2 * MiB;
enum { RB_ATTN = 0, RB_FFN = 1, RB_GATE = 2, RB_PE = 3, RB_MLA = 4 };

__device__ __forceinline__ unsigned f2bf(float f) { unsigned u = __builtin_bit_cast(unsigned, f); return (u + 0x7fffu + ((u >> 16) & 1u)) >> 16; }
__device__ __forceinline__ unsigned pk2(float lo, float hi) { return pg8::cvt_pk_bf16(lo, hi); }
__device__ __forceinline__ float bflo(unsigned u) { return __builtin_bit_cast(float, u << 16); }
__device__ __forceinline__ float bfhi(unsigned u) { return __builtin_bit_cast(float, u & 0xffff0000u); }
__device__ __forceinline__ v2u pk4(f32x4 v) { v2u o; o.x = pk2(v[0], v[1]); o.y = pk2(v[2], v[3]); return o; }
__device__ __forceinline__ f32x4 unpk4(v2u u) { return (f32x4){bflo(u.x), bfhi(u.x), bflo(u.y), bfhi(u.y)}; }
__device__ __forceinline__ float sigmoidf_(float x) { return 1.0f / (1.0f + __expf(-x)); }
__device__ __forceinline__ float softplusf_(float x) { return fmaxf(x, 0.f) + __logf(1.0f + __expf(-fabsf(x))); }
__device__ __forceinline__ float tanhf_(float x) { const float e = __expf(-2.0f * fabsf(x)); const float r = (1.0f - e) / (1.0f + e); return x < 0.f ? -r : r; }
__device__ __forceinline__ float rstd_of(const float* rsp, int row, float invn, int nslot4 = 4) { const f32x4* p = (const f32x4*)(rsp + (size_t)row * 32); float s = 0.f;
    for (int i = 0; i < nslot4; ++i) { const f32x4 v = p[i]; s += (v[0] + v[1]) + (v[2] + v[3]); } return rsqrtf(s * invn + EPS); }
__device__ __forceinline__ int crow(int r, int hi) { return (r & 3) + 8 * (r >> 2) + 4 * hi; }

#define EPI_HEAD const int rowb = u.pm * 256 + wr * 64 + fr; const int colb = u.pn * 256 + wc * 32 + 4 * fq; (void)rowb; (void)colb;
#define EPI_ROWS _Pragma("unroll") for (int ai = 0; ai < 2; ++ai) _Pragma("unroll") for (int m = 0; m < 4; ++m) for (int once_ = (__builtin_amdgcn_sched_barrier(0), 0); once_ < 1; ++once_, ({ asm volatile("" ::: "memory"); }))
#define EPI_ROWS_NF _Pragma("unroll") for (int ai = 0; ai < 2; ++ai) _Pragma("unroll") for (int m = 0; m < 4; ++m)
#define EPI_COLS _Pragma("unroll") for (int bj = 0; bj < 2; ++bj) _Pragma("unroll") for (int n = 0; n < 2; ++n)
typedef const f32x4 (&AccRef)[2][2][4][2];

struct EpiHybIn { static constexpr bool PERM = false, AFTER_DRAIN = false;
    int layer;
    __device__ __forceinline__ void operator()(AccRef acc, const Unit& u, int wr, int wc, int fr, int fq) const { EPI_HEAD unsigned char* wsb = P_WS; const float* rss = (float*)(wsb + WS_R + R_RSP + RB_ATTN * RSP_BYTES); bf16* qk = (bf16*)(wsb + WS_R + R_QK); bf16* vt = (bf16*)(wsb + WS_R + R_VTSB); bf16* rwp = (bf16*)(wsb + WS_R + R_RWP);
        EPI_ROWS_NF { const int row = rowb + ai * 128 + m * 16; const float rs = rstd_of(rss, row, 1.f / 1024.f);
            EPI_COLS { const int col = colb + bj * 128 + n * 16; const f32x4 v = acc[ai][bj][m][n] * rs;
                if (col < 1024) { const f32x4 w = col < 512 ? v * 0.125f : v; *(v2u*)(qk + (size_t)row * 1024 + col) = pk4(w); }
                else if (col < 1536) { const int c = col - 1024, hh = c >> 6, d = c & 63, b = row >> 13, t = row & 8191; bf16* p = vt + ((size_t)((b * 8 + hh) * 64 + d)) * SEQ + t;
                    p[0] = (bf16)f2bf(v[0]); p[SEQ] = (bf16)f2bf(v[1]); p[2 * SEQ] = (bf16)f2bf(v[2]); p[3 * SEQ] = (bf16)f2bf(v[3]); }
                else if (col < 3360) { *(v2u*)(rwp + (size_t)row * RWP_LD + (col - 1536)) = pk4(v); } } }
    } };

struct EpiLora { static constexpr bool PERM = false, AFTER_DRAIN = false;
    int layer;
    __device__ __forceinline__ void operator()(AccRef acc, const Unit& u, int wr, int wc, int fr, int fq) const { EPI_HEAD unsigned char* wsb = P_WS; const int jl = layer >> 1; float* scanop = (float*)(wsb + WS_R + R_SCAN); bf16* g = (bf16*)(wsb + WS_R + R_G); const float* w0 = ptr(16) + (size_t)jl * 512; const float* a0 = ptr(18) + (size_t)jl * 512; const float* k_a = ptr(22) + (size_t)jl * 512;
        EPI_ROWS_NF { const int row = rowb + ai * 128 + m * 16; const int b = row >> 13, t = row & 8191;
            EPI_COLS { const int col = colb + bj * 128 + n * 16; const f32x4 v = acc[ai][bj][m][n];
                if (col < 512) { const int c = col; float* base = scanop + ((size_t)(b * 8 + (c >> 6)) * SEQ + t) * 320 + (c & 63); const f32x4 w0v = *(const f32x4*)(w0 + c); f32x4 o;
                    _Pragma("unroll") for (int j = 0; j < 4; ++j) { const float wv = -softplusf_(-(w0v[j] + v[j])) - 0.5f; o[j] = __expf(-__expf(wv)); }
                    *(f32x4*)(base + 64) = o; }
                else if (col < 1024) { const int c = col - 512; float* base = scanop + ((size_t)(b * 8 + (c >> 6)) * SEQ + t) * 320 + (c & 63); const f32x4 a0v = *(const f32x4*)(a0 + c), kav = *(const f32x4*)(k_a + c);
                    const f32x4 kk = *(const f32x4*)(base), k = *(const f32x4*)(base + 192); f32x4 oka, ok;
                    _Pragma("unroll") for (int j = 0; j < 4; ++j) { const float a = sigmoidf_(a0v[j] + v[j]); oka[j] = kk[j] * a; ok[j] = k[j] * (1.0f + (a - 1.0f) * kav[j]); }
                    *(f32x4*)(base + 128) = oka; *(f32x4*)(base + 192) = ok; }
                else { *(v2u*)(g + (size_t)row * 512 + (col - 1024)) = pk4(v); } } }
    } };

struct EpiResid { static constexpr bool PERM = false, AFTER_DRAIN = false;
    int layer; int mode;
    __device__ __forceinline__ void operator()(AccRef acc, const Unit& u, int wr, int wc, int fr, int fq) const { EPI_HEAD unsigned char* wsb = P_WS; float* h = P_H; bf16* hA = (bf16*)(wsb + WS_HA); const float* gnext = ptr(mode == 0 ? 4 : 11) + (size_t)layer * 1024; float* rss_next = (float*)(wsb + WS_R + R_RSP + (mode == 0 ? RB_FFN : RB_GATE) * RSP_BYTES);
        EPI_ROWS_NF { const int row = rowb + ai * 128 + m * 16; float ss = 0.f;
            EPI_COLS { const int col = colb + bj * 128 + n * 16; float* hp = h + (size_t)row * 1024 + col; const f32x4 hv = *(const f32x4*)hp + acc[ai][bj][m][n]; *(f32x4*)hp = hv;
                ss += (hv[0] * hv[0] + hv[1] * hv[1]) + (hv[2] * hv[2] + hv[3] * hv[3]);
                if (hA) { const f32x4 gv = *(const f32x4*)(gnext + col); *(v2u*)(hA + (size_t)row * 1024 + col) = pk4(hv * gv); } }
            ss += __shfl_xor(ss, 16); ss += __shfl_xor(ss, 32); if (fq == 0) rss_next[(size_t)row * 32 + u.pn * 4 + wc] = ss; }
    } };

struct EpiPleGate { static constexpr bool PERM = false, AFTER_DRAIN = false;
    int layer;
    __device__ __forceinline__ void operator()(AccRef acc, const Unit& u, int wr, int wc, int fr, int fq) const { EPI_HEAD unsigned char* wsb = P_WS; float* h = P_H; bf16* hA = layer < 3 ? (bf16*)(wsb + WS_R + R_HA2) : (bf16*)nullptr; const float* gnext = ptr(3) + (size_t)(layer < 3 ? layer + 1 : 0) * 1024; float* rss_next = (float*)(wsb + WS_R + R_RSP + RB_ATTN * RSP_BYTES); const float* rss_gate = (float*)(wsb + WS_R + R_RSP + RB_GATE * RSP_BYTES); const float* rss_pe = (float*)(wsb + WS_R + R_RSP + RB_PE * RSP_BYTES); const bf16* pe = (const bf16*)(wsb + WS_R + R_PE); const float* ple_norm = ptr(10) + (size_t)layer * 1024;
        EPI_ROWS_NF { const int row = rowb + ai * 128 + m * 16; float ss = 0.f; const float rg = rstd_of(rss_gate, row, 1.f / 1024.f), rp = rstd_of(rss_pe, row, 1.f / 1024.f);
            EPI_COLS { const int col = colb + bj * 128 + n * 16; float* hp = h + (size_t)row * 1024 + col; const f32x4 a = acc[ai][bj][m][n] * rg;
                const f32x4 e = unpk4(*(const v2u*)(pe + (size_t)row * 1024 + col)) * rp * *(const f32x4*)(ple_norm + col); f32x4 hv = *(const f32x4*)hp;
                _Pragma("unroll") for (int j = 0; j < 4; ++j) hv[j] += sigmoidf_(a[j]) * e[j];
                *(f32x4*)hp = hv; ss += (hv[0] * hv[0] + hv[1] * hv[1]) + (hv[2] * hv[2] + hv[3] * hv[3]);
                if (hA) { const f32x4 gv = *(const f32x4*)(gnext + col); *(v2u*)(hA + (size_t)row * 1024 + col) = pk4(hv * gv); } }
            ss += __shfl_xor(ss, 16); ss += __shfl_xor(ss, 32); if (fq == 0) rss_next[(size_t)row * 32 + u.pn * 4 + wc] = ss; }
    } };

struct EpiFfnG { static constexpr bool PERM = false, AFTER_DRAIN = false;
    int layer;
    __device__ __forceinline__ void operator()(AccRef acc, const Unit& u, int wr, int wc, int fr, int fq) const { EPI_HEAD unsigned char* wsb = P_WS; const float* rss = (float*)(wsb + WS_R + R_RSP + RB_FFN * RSP_BYTES); bf16* gate_in = (bf16*)(wsb + WS_R + R_GATE);
        EPI_ROWS_NF { const int row = rowb + ai * 128 + m * 16; const float rs = rstd_of(rss, row, 1.f / 1024.f); if (u.pn == 0 && wc == 0 && fq == 0) ((float*)rss)[(size_t)row * 32 + 16] = rs;
            EPI_COLS { const int col = colb + bj * 128 + n * 16; *(v2u*)(gate_in + (size_t)row * FFN + col) = pk4(acc[ai][bj][m][n] * rs); } }
    } };

struct EpiFfnU { static constexpr bool PERM = false, AFTER_DRAIN = false;
    int layer;
    __device__ __forceinline__ void operator()(AccRef acc, const Unit& u, int wr, int wc, int fr, int fq) const { unsigned char* wsb = P_WS; const float* rss = (float*)(wsb + WS_R + R_RSP + RB_FFN * RSP_BYTES); const bf16* gate_in = (const bf16*)(wsb + WS_R + R_GATE); bf16* act = (bf16*)(wsb + WS_R + R_ACT); const float* cw = ptr(6) + (size_t)layer * 3 * FFN; const float* cb = ptr(7) + (size_t)layer * FFN;
        const int rowb = u.pm * 256 + wr * 64 + fr, colb = u.pn * 256 + wc * 32 + 4 * fq;
        _Pragma("unroll") for (int bj = 0; bj < 2; ++bj) _Pragma("unroll") for (int n = 0; n < 2; ++n) { const int col = colb + bj * 128 + 16 * n;
            const f32x4 c0 = *(const f32x4*)(cw + col), c1 = *(const f32x4*)(cw + FFN + col), c2 = *(const f32x4*)(cw + 2 * FFN + col), cbv = *(const f32x4*)(cb + col);
            _Pragma("unroll") for (int r = 0; r < 8; ++r) { const int row = rowb + (r >> 2) * 128 + (r & 3) * 16; const int t = row & 8191; const bf16* gp = gate_in + (size_t)row * FFN + col;
                const v2u q0 = *(const v2u*)gp, q1 = *(const v2u*)(gp - (t >= 1 ? FFN : 0)), q2 = *(const v2u*)(gp - (t >= 2 ? 2 * FFN : 0));
                const f32x4 uu = acc[r >> 2][bj][r & 3][n] * rss[(size_t)row * 32 + 16]; const f32x4 g0 = unpk4(q0); f32x4 g1 = unpk4(q1), g2 = unpk4(q2);
                if (t < 1) g1 = (f32x4){0.f, 0.f, 0.f, 0.f}; if (t < 2) g2 = (f32x4){0.f, 0.f, 0.f, 0.f};
                const f32x4 cc = c0 * g2 + c1 * g1 + c2 * g0 + cbv;
                const pg8::f32x2 ga = pg8::gelu_pk((pg8::f32x2){cc[0], cc[1]}), gb = pg8::gelu_pk((pg8::f32x2){cc[2], cc[3]});
                *(v2u*)(act + (size_t)row * FFN + col) = (v2u){pk2(ga.x * uu[0], ga.y * uu[1]), pk2(gb.x * uu[2], gb.y * uu[3])}; if ((r & 3) == 3) asm volatile("" ::: "memory"); } }
    } };

struct EpiPe { static constexpr bool PERM = false, AFTER_DRAIN = false;
    int layer;
    __device__ __forceinline__ void operator()(AccRef acc, const Unit& u, int wr, int wc, int fr, int fq) const { EPI_HEAD unsigned char* wsb = P_WS; bf16* pe = (bf16*)(wsb + WS_R + R_PE); float* rss_pe = (float*)(wsb + WS_R + R_RSP + RB_PE * RSP_BYTES);
        EPI_ROWS_NF { const int row = rowb + ai * 128 + m * 16; float ss = 0.f;
            EPI_COLS { const int col = colb + bj * 128 + n * 16; const f32x4 v = acc[ai][bj][m][n]; ss += (v[0] * v[0] + v[1] * v[1]) + (v[2] * v[2] + v[3] * v[3]); *(v2u*)(pe + (size_t)row * 1024 + col) = pk4(v); }
            ss += __shfl_xor(ss, 16); ss += __shfl_xor(ss, 32); if (fq == 0) rss_pe[(size_t)row * 32 + u.pn * 4 + wc] = ss; }
    } };

__device__ __forceinline__ void rope4(const float* tab, int row, int fq, f32x4 x1, f32x4 x2, f32x4& o1, f32x4& o2) {
    const f32x4 cs = *(const f32x4*)(tab + (size_t)row * 32 + 4 * fq), sn = *(const f32x4*)(tab + (size_t)row * 32 + 16 + 4 * fq);
    o1 = x1 * cs - x2 * sn; o2 = x1 * sn + x2 * cs;
}

struct EpiMlaDown { static constexpr bool PERM = false, AFTER_DRAIN = false;
    int layer;
    __device__ __forceinline__ void operator()(AccRef acc, const Unit& u, int wr, int wc, int fr, int fq) const { EPI_HEAD unsigned char* wsb = P_WS; const int jl = layer >> 1; const float* rss = (float*)(wsb + WS_R + R_RSP + RB_ATTN * RSP_BYTES); bf16* cq = (bf16*)(wsb + WS_R + R_CQ); bf16* ckv = (bf16*)(wsb + WS_R + R_CKV); bf16* krope = (bf16*)(wsb + WS_R + R_KROPE); const float* q_norm = ptr(27) + (size_t)jl * 384; const float* kv_norm = ptr(28) + (size_t)jl * 256; float* rss_mla = (float*)(wsb + WS_R + R_RSP + RB_MLA * RSP_BYTES); (void)jl; const float* tab = (const float*)(wsb + WS_ROPE);
        EPI_ROWS_NF { const int row = rowb + ai * 128 + m * 16; const float rs = rstd_of(rss, row, 1.f / 1024.f);
            _Pragma("unroll") for (int bj = 0; bj < 2; ++bj) { const int cb0 = u.pn * 256 + bj * 128;
                if (cb0 < 640) { float ss = 0.f;
                    _Pragma("unroll") for (int n = 0; n < 2; ++n) { const int col = colb + bj * 128 + n * 16; const f32x4 v = acc[ai][bj][m][n] * rs; ss += (v[0] * v[0] + v[1] * v[1]) + (v[2] * v[2] + v[3] * v[3]);
                        if (cb0 < 384) *(v2u*)(cq + (size_t)row * 384 + col) = pk4(v * *(const f32x4*)(q_norm + col));
                        else *(v2u*)(ckv + (size_t)row * 256 + (col - 384)) = pk4(v * *(const f32x4*)(kv_norm + col - 384)); }
                    ss += __shfl_xor(ss, 16); ss += __shfl_xor(ss, 32); if (fq == 0) rss_mla[(size_t)row * 32 + (u.pn * 2 + bj) * 4 + wc] = ss; }
                else if (cb0 == 640 && wc == 0) { f32x4 o1, o2; rope4(tab, row, fq, acc[ai][bj][m][0] * rs, acc[ai][bj][m][1] * rs, o1, o2);
                    *(v2u*)(krope + (size_t)row * 32 + 4 * fq) = pk4(o1); *(v2u*)(krope + (size_t)row * 32 + 16 + 4 * fq) = pk4(o2); } } }
    } };

constexpr float QSCALE = 0.10206207261596575f * 1.4426950408889634f;
struct EpiUq { static constexpr bool PERM = false, AFTER_DRAIN = false;
    int layer;
    __device__ __forceinline__ void operator()(AccRef acc, const Unit& u, int wr, int wc, int fr, int fq) const { EPI_HEAD unsigned char* wsb = P_WS; const float* rss_cq = (float*)(wsb + WS_R + R_RSP + RB_MLA * RSP_BYTES); bf16* q = (bf16*)(wsb + WS_R + R_Q); const float* tab = (const float*)(wsb + WS_ROPE);
        EPI_ROWS_NF { const int row = rowb + ai * 128 + m * 16; const float rs = rstd_of(rss_cq, row, 1.f / 384.f, 3) * QSCALE;
            _Pragma("unroll") for (int bj = 0; bj < 2; ++bj) { const int c0 = u.pn * 256 + bj * 128 + wc * 32; bf16* qp = q + (size_t)row * 1536 + c0 + 4 * fq;
                f32x4 v0 = acc[ai][bj][m][0] * rs, v1 = acc[ai][bj][m][1] * rs;
                if (((c0 >> 5) % 3) == 2) { f32x4 o1, o2; rope4(tab, row, fq, v0, v1, o1, o2); v0 = o1; v1 = o2; }
                *(v2u*)qp = pk4(v0); *(v2u*)(qp + 16) = pk4(v1); } }
    } };

struct EpiUkv { static constexpr bool PERM = false, AFTER_DRAIN = false;
    int layer;
    __device__ __forceinline__ void operator()(AccRef acc, const Unit& u, int wr, int wc, int fr, int fq) const { EPI_HEAD unsigned char* wsb = P_WS; const float* rss_ckv = (float*)(wsb + WS_R + R_RSP + RB_MLA * RSP_BYTES) + 12; bf16* kn = (bf16*)(wsb + WS_R + R_KN); bf16* vt = (bf16*)(wsb + WS_R + R_VT);
        EPI_ROWS_NF { const int row = rowb + ai * 128 + m * 16; const float rs = rstd_of(rss_ckv, row, 1.f / 256.f, 2); const int b = row >> 13, t = row & 8191;
            EPI_COLS { const int col = colb + bj * 128 + n * 16; const int hh = col >> 7, wi = col & 127; const f32x4 v = acc[ai][bj][m][n] * rs;
                if (wi < 64) *(v2u*)(kn + (size_t)row * 1024 + hh * 64 + wi) = pk4(v);
                else { bf16* p = vt + ((size_t)((b * 16 + hh) * 64 + (wi - 64))) * SEQ + t; p[0] = (bf16)f2bf(v[0]); p[SEQ] = (bf16)f2bf(v[1]); p[2 * SEQ] = (bf16)f2bf(v[2]); p[3 * SEQ] = (bf16)f2bf(v[3]); } } }
    } };

#ifndef GEMM_MASK
#define GEMM_MASK 0xFFFF
#endif
template <int ID, class E> __device__ __forceinline__ void run_gemm(LAS unsigned char* lds, const bf16* A, const bf16* Bt, int M, int N, int K, const E& e) {
    asm volatile("" : "+s"(K)); asm volatile("" : "+s"(N));
    pg8::Gemm g{A, Bt, M, N, K}; pg8::StaticOrder S; S.init(M, N, (int)gridDim.x, (int)blockIdx.x);
#if PH_GEMM
    if constexpr ((GEMM_MASK >> ID) & 1) pg8::gemm_phase<E, pg8::StaticOrder, true, true>(lds, g, S, e);
#endif
}

struct Ctx { int tid, lane, wid, gw, NGW; unsigned char* lds; };
__device__ __forceinline__ Ctx mk_ctx() { Ctx c; int t = threadIdx.x; asm volatile("" : "+v"(t)); int b = blockIdx.x; asm volatile("" : "+s"(b));
    c.tid = t; c.lane = t & 63; c.wid = __builtin_amdgcn_readfirstlane(t >> 6); c.gw = b * 8 + c.wid; c.NGW = gridDim.x * 8; c.lds = g_lds; return c; }
#define LDS_WAIT() asm volatile("s_waitcnt lgkmcnt(0)" ::: "memory")

__device__ __forceinline__ void transpose_mat(const Ctx& c, const float* W, int K, int N, bf16* WT) {
    float* scr = (float*)(c.lds + c.wid * 16384); const int items = (K / 64) * (N / 32), nblk = N / 32, lane = c.lane;
    float tv[32];
    int it = c.gw;
    if (it < items) { const int k0 = 64 * (it / nblk), n0 = 32 * (it % nblk);
#pragma unroll
        for (int i = 0; i < 32; ++i) tv[i] = W[(size_t)(k0 + 2 * i + (lane >> 5)) * N + n0 + (lane & 31)]; }
    for (; it < items; it += c.NGW) { const int k0 = 64 * (it / nblk), n0 = 32 * (it % nblk);
#pragma unroll
        for (int i = 0; i < 32; ++i) scr[(2 * i + (lane >> 5)) * 33 + (lane & 31)] = tv[i];
        const int nx = it + c.NGW;
        if (nx < items) { const int k1 = 64 * (nx / nblk), n1 = 32 * (nx % nblk);
#pragma unroll
            for (int i = 0; i < 32; ++i) tv[i] = W[(size_t)(k1 + 2 * i + (lane >> 5)) * N + n1 + (lane & 31)]; }
        LDS_WAIT(); asm volatile("" ::: "memory");
        const int cc = lane & 7;
#pragma unroll
        for (int j = 0; j < 4; ++j) { const int n = (lane >> 3) + 8 * j; const float* s = scr + (8 * cc) * 33 + n;
            v4u o; o.x = pk2(s[0 * 33], s[1 * 33]); o.y = pk2(s[2 * 33], s[3 * 33]); o.z = pk2(s[4 * 33], s[5 * 33]); o.w = pk2(s[6 * 33], s[7 * 33]);
            *(v4u*)(WT + (size_t)(n0 + n) * K + k0 + 8 * cc) = o; }
        LDS_WAIT(); asm volatile("" ::: "memory");
    }
}
__device__ __forceinline__ void zero_bytes16(const Ctx& c, void* p, size_t bytes) {
    v4u* q = (v4u*)p; const size_t n = bytes / 16; const v4u z = {0u, 0u, 0u, 0u};
    for (size_t i = (size_t)c.gw * 64 + c.lane; i < n; i += (size_t)c.NGW * 64) q[i] = z;
}
struct In { __device__ __forceinline__ const float* operator[](int i) const { return ptr(i); } };
__device__ __forceinline__ void conv_mixer(const Ctx&, const In& in, unsigned char* ws, int layer) { const Ctx c = mk_ctx();
    const int j = layer >> 1; unsigned char* W = ws + WS_W;
    if ((layer & 1) == 0) {
        transpose_mat(c, in[13] + (size_t)j * 1024 * 3360, 1024, 3360, (bf16*)(W + W_HYBIN));
        zero_bytes16(c, W + W_HYBIN + (size_t)3360 * 1024 * 2, (size_t)224 * 1024 * 2);
        transpose_mat(c, in[14] + (size_t)j * 1024 * 1024, 1024, 1024, (bf16*)(W + W_HYBOUT));
        bf16* L = (bf16*)(W + W_LORA); const float* w2 = in[17] + (size_t)j * 64 * 512; const float* a2 = in[19] + (size_t)j * 64 * 512; const float* g2 = in[20] + (size_t)j * 160 * 512;
        for (int i = c.gw * 64 + c.lane; i < 1536 * 384; i += c.NGW * 64) { const int n = i / 384, k = i % 384; float v = 0.f;
            if (n < 512) { if (k < 64) v = w2[k * 512 + n]; } else if (n < 1024) { if (k >= 64 && k < 128) v = a2[(k - 64) * 512 + n - 512]; } else { if (k >= 128 && k < 288) v = g2[(k - 128) * 512 + n - 1024]; }
            L[i] = (bf16)f2bf(v); }
    } else {
        transpose_mat(c, in[26] + (size_t)j * 1024 * 672, 1024, 672, (bf16*)(W + W_DOWN));
        zero_bytes16(c, W + W_DOWN + (size_t)672 * 1024 * 2, (size_t)96 * 1024 * 2);
        transpose_mat(c, in[29] + (size_t)j * 384 * 1536, 384, 1536, (bf16*)(W + W_UQ));
        transpose_mat(c, in[30] + (size_t)j * 256 * 2048, 256, 2048, (bf16*)(W + W_UKV));
        transpose_mat(c, in[31] + (size_t)j * 1024 * 1024, 1024, 1024, (bf16*)(W + W_WO));
    }
}
__device__ __forceinline__ void conv_ffn(const Ctx&, const In& in, unsigned char* ws, int layer) { const Ctx c = mk_ctx();
    unsigned char* W = ws + WS_W;
    transpose_mat(c, in[5] + (size_t)layer * 1024 * 5632, 1024, 5632, (bf16*)(W + W_FFNIN));
    transpose_mat(c, in[8] + (size_t)layer * 2816 * 1024, 2816, 1024, (bf16*)(W + W_FFNOUT));
    transpose_mat(c, in[9] + (size_t)layer * 256 * 1024, 256, 1024, (bf16*)(W + W_PLEP));
    transpose_mat(c, in[12] + (size_t)layer * 1024 * 1024, 1024, 1024, (bf16*)(W + W_PLEG));
}
__device__ __forceinline__ void conv_p(const Ctx&, const In& in, unsigned char* ws, int layer) { const Ctx c = mk_ctx();
    const f32x4* src = (const f32x4*)(in[1] + (size_t)layer * T * 256); v2u* dst = (v2u*)(ws + WS_PB);
    for (int i = c.gw * 64 + c.lane; i < T * 256 / 4; i += c.NGW * 64) dst[i] = pk4(src[i]);
}
__device__ __forceinline__ float wave_sum(float v) {
#pragma unroll
    for (int o = 1; o < 64; o <<= 1) v += __shfl_xor(v, o);
    return v;
}
__device__ __forceinline__ void phase0(const Ctx&, const In& in, float* h, unsigned char* ws) { const Ctx c = mk_ctx();
    float* rss = (float*)(ws + WS_R + R_RSP + RB_ATTN * RSP_BYTES);
    float* tab = (float*)(ws + WS_ROPE); const int* pos = (const int*)in[2];
    for (int i = c.gw * 64 + c.lane; i < T * 16; i += c.NGW * 64) { const int row = i >> 4, k = i & 15;
        const float inv = exp2f(-(float)k * (13.287712379549449f / 16.0f)); const float ang = (float)pos[row] * inv;
        const float kq = rintf(ang * 0.15915494309189535f); float r = fmaf(-kq, 6.28125f, ang); r = fmaf(-kq, 0.0019353071795864769f, r);
        tab[row * 32 + k] = cosf(r); tab[row * 32 + 16 + k] = sinf(r); }
    const float* x = in[0]; const float* g0 = in[3]; bf16* hA = (bf16*)(ws + WS_R + R_HA2);
    for (int row = c.gw; row < T; row += c.NGW) { float s = 0.f;
#pragma unroll
        for (int j = 0; j < 4; ++j) { const int col = 4 * c.lane + 256 * j; const f32x4 v = *(const f32x4*)(x + (size_t)row * 1024 + col); *(f32x4*)(h + (size_t)row * 1024 + col) = v;
            s += (v[0] * v[0] + v[1] * v[1]) + (v[2] * v[2] + v[3] * v[3]); *(v2u*)(hA + (size_t)row * 1024 + col) = pk4(v * *(const f32x4*)(g0 + col)); }
        s = wave_sum(s); if (c.lane < 16) rss[(size_t)row * 32 + c.lane] = c.lane == 0 ? s : 0.f; }
}
__device__ __forceinline__ void phase_final(const Ctx&, const In& in, float* h, unsigned char* ws) { const Ctx c = mk_ctx();
    const float* rss = (const float*)(ws + WS_R + R_RSP + RB_ATTN * RSP_BYTES); const float* g = in[32];
    for (int row = c.gw; row < T; row += c.NGW) { const float rs = rstd_of(rss, row, 1.f / 1024.f);
#pragma unroll
        for (int j = 0; j < 4; ++j) { const int col = 4 * c.lane + 256 * j; float* hp = h + (size_t)row * 1024 + col; *(f32x4*)hp = *(const f32x4*)hp * rs * *(const f32x4*)(g + col); } }
}

#define MFMA32(a, b, c) __builtin_amdgcn_mfma_f32_32x32x16_bf16((a), (b), (c), 0, 0, 0)
__device__ __forceinline__ bf16x8 pack8(const f32x16& x, int s) {
    v4u p; p.x = pk2(x[8 * s], x[8 * s + 1]); p.y = pk2(x[8 * s + 2], x[8 * s + 3]); p.z = pk2(x[8 * s + 4], x[8 * s + 5]); p.w = pk2(x[8 * s + 6], x[8 * s + 7]);
    return __builtin_bit_cast(bf16x8, p);
}
__device__ __forceinline__ bf16x8 cat4(v2u lo, v2u hi) { v4u p; p.x = lo.x; p.y = lo.y; p.z = hi.x; p.w = hi.y; return __builtin_bit_cast(bf16x8, p); }

__device__ __forceinline__ void sb_attn_phase(const Ctx&, bf16* qk, const bf16* vt) { const Ctx c = mk_ctx();
    const int r = c.lane & 31, hi = c.lane >> 5;
    for (int task = (int)blockIdx.x * 4 + (c.wid - 4); task < 16 * 256; task += (int)gridDim.x * 4) {
        const int chain = task >> 8, qblk = task & 255, b = chain >> 3, h = chain & 7, q0 = qblk * 32; const size_t rowbase = (size_t)b * SEQ;
        bf16x8 qr[4];
#pragma unroll
        for (int s = 0; s < 4; ++s) qr[s] = *(const bf16x8*)(qk + (rowbase + q0 + r) * 1024 + h * 64 + 16 * s + 8 * hi);
        f32x16 o[2]; o[0] = f32x16{}; o[1] = f32x16{}; float carry = 0.f;
        for (int jt = qblk; jt >= 0; --jt) { const int k0 = jt * 32;
            f32x16 z = f32x16{};
#pragma unroll
            for (int s = 0; s < 4; ++s) { const bf16x8 kf = *(const bf16x8*)(qk + (rowbase + k0 + r) * 1024 + 512 + h * 64 + 16 * s + 8 * hi); z = MFMA32(kf, qr[s], z); }
            const bool diag = (jt == qblk);
            f32x16 lom;
#pragma unroll
            for (int i = 0; i < 16; ++i) { const bool msk = diag && (crow(i, hi) >= r); lom[i] = msk ? 0.f : -softplusf_(z[i]); }
            float Tg[4], To[4]; f32x16 aft;
#pragma unroll
            for (int g = 0; g < 4; ++g) { aft[4 * g + 3] = 0.f; aft[4 * g + 2] = lom[4 * g + 3]; aft[4 * g + 1] = aft[4 * g + 2] + lom[4 * g + 2]; aft[4 * g] = aft[4 * g + 1] + lom[4 * g + 1]; Tg[g] = aft[4 * g] + lom[4 * g]; To[g] = __shfl_xor(Tg[g], 32); }
            float E = carry;
#pragma unroll
            for (int g = 3; g >= 0; --g) { const float off = E + (hi == 0 ? To[g] : 0.f);
#pragma unroll
                for (int e = 0; e < 4; ++e) { const int i = 4 * g + e; const bool msk = diag && (crow(i, hi) >= r); const float w = __expf(z[i] + lom[i] + aft[i] + off); z[i] = msk ? 0.f : w; }
                E += Tg[g] + To[g]; }
            carry = E;
            const bf16x8 pa0 = pack8(z, 0), pa1 = pack8(z, 1);
#pragma unroll
            for (int db = 0; db < 2; ++db) { const bf16* vp = vt + ((size_t)(chain * 64 + 32 * db + r)) * SEQ + k0 + 4 * hi;
                const bf16x8 v0 = cat4(*(const v2u*)(vp), *(const v2u*)(vp + 8)), v1 = cat4(*(const v2u*)(vp + 16), *(const v2u*)(vp + 24));
                o[db] = MFMA32(v0, pa0, o[db]); o[db] = MFMA32(v1, pa1, o[db]); }
            if (__all(carry < -40.0f)) break;
        }
        bf16* op = qk + (rowbase + q0 + r) * 1024 + h * 64;
#pragma unroll
        for (int db = 0; db < 2; ++db)
#pragma unroll
            for (int g = 0; g < 4; ++g) *(v2u*)(op + 32 * db + 8 * g + 4 * hi) = pk4((f32x4){o[db][4 * g], o[db][4 * g + 1], o[db][4 * g + 2], o[db][4 * g + 3]});
    }
}

__device__ __forceinline__ void rw_prep_phase(const Ctx&, const In& in, unsigned char* ws, int j) { const Ctx c = mk_ctx();
    const bf16* rwp = (const bf16*)(ws + WS_R + R_RWP); float* scanop = (float*)(ws + WS_R + R_SCAN); bf16* vbf = (bf16*)(ws + WS_HA + HA_VBF); bf16* acat = (bf16*)(ws + WS_HA + HA_ACAT);
    const float* mu = in[15] + (size_t)j * 1824; const float* k_k = in[21] + (size_t)j * 512;
    const int lane = c.lane, hh = lane >> 3, n0 = (lane & 7) * 8;
    for (int row = c.gw; row < T; row += c.NGW) { const int b = row >> 13, t = row & 8191; const bf16* cur = rwp + (size_t)row * RWP_LD; const bool hp = t > 0;
        float xm[3][8];
#pragma unroll
        for (int part = 0; part < 3; ++part) { const int ch = part * 512 + hh * 64 + n0; const v4u cu = *(const v4u*)(cur + ch); v4u pu = {0u, 0u, 0u, 0u}; if (hp) pu = *(const v4u*)(cur - RWP_LD + ch);
            const f32x4 m0 = *(const f32x4*)(mu + ch), m1 = *(const f32x4*)(mu + ch + 4);
#pragma unroll
            for (int q = 0; q < 4; ++q) { const float p0 = bflo(cu[q]), p1 = bfhi(cu[q]), a0 = bflo(pu[q]), a1 = bfhi(pu[q]); const float mm0 = q < 2 ? m0[2 * q] : m1[2 * q - 4], mm1 = q < 2 ? m0[2 * q + 1] : m1[2 * q - 3];
                xm[part][2 * q] = p0 + (a0 - p0) * mm0; xm[part][2 * q + 1] = p1 + (a1 - p1) * mm1; } }
        float* base = scanop + ((size_t)(b * 8 + hh) * SEQ + t) * 320 + n0;
        *(f32x4*)(base + 256) = (f32x4){xm[0][0], xm[0][1], xm[0][2], xm[0][3]}; *(f32x4*)(base + 260) = (f32x4){xm[0][4], xm[0][5], xm[0][6], xm[0][7]};
        *(f32x4*)(base + 192) = (f32x4){xm[1][0], xm[1][1], xm[1][2], xm[1][3]}; *(f32x4*)(base + 196) = (f32x4){xm[1][4], xm[1][5], xm[1][6], xm[1][7]};
        const f32x4 kk0 = *(const f32x4*)(k_k + hh * 64 + n0), kk1 = *(const f32x4*)(k_k + hh * 64 + n0 + 4); float kk[8]; float ss = 0.f;
#pragma unroll
        for (int q = 0; q < 8; ++q) { kk[q] = xm[1][q] * (q < 4 ? kk0[q] : kk1[q - 4]); ss += kk[q] * kk[q]; }
        ss += __shfl_xor(ss, 1); ss += __shfl_xor(ss, 2); ss += __shfl_xor(ss, 4);
        const float rn = rsqrtf(fmaxf(ss, 1e-24f));
        *(f32x4*)(base) = (f32x4){kk[0] * rn, kk[1] * rn, kk[2] * rn, kk[3] * rn}; *(f32x4*)(base + 4) = (f32x4){kk[4] * rn, kk[5] * rn, kk[6] * rn, kk[7] * rn};
        { v4u o; o.x = pk2(xm[2][0], xm[2][1]); o.y = pk2(xm[2][2], xm[2][3]); o.z = pk2(xm[2][4], xm[2][5]); o.w = pk2(xm[2][6], xm[2][7]); *(v4u*)(vbf + ((size_t)(b * 8 + hh) * SEQ + t) * 64 + n0) = o; }
        if (lane < 48) { v4u o = {0u, 0u, 0u, 0u};
            if (lane < 36) { const int ch = 1536 + 8 * lane; const v4u cu = *(const v4u*)(cur + ch); v4u pu = {0u, 0u, 0u, 0u}; if (hp) pu = *(const v4u*)(cur - RWP_LD + ch);
                const f32x4 m0 = *(const f32x4*)(mu + ch), m1 = *(const f32x4*)(mu + ch + 4); float y[8];
#pragma unroll
                for (int q = 0; q < 4; ++q) { const float p0 = bflo(cu[q]), p1 = bfhi(cu[q]), a0 = bflo(pu[q]), a1 = bfhi(pu[q]); const float mm0 = q < 2 ? m0[2 * q] : m1[2 * q - 4], mm1 = q < 2 ? m0[2 * q + 1] : m1[2 * q - 3];
                    y[2 * q] = p0 + (a0 - p0) * mm0; y[2 * q + 1] = p1 + (a1 - p1) * mm1; }
#pragma unroll
                for (int q = 0; q < 8; ++q) y[q] = lane < 8 ? tanhf_(y[q]) : (lane < 16 ? y[q] : sigmoidf_(y[q]));
                o.x = pk2(y[0], y[1]); o.y = pk2(y[2], y[3]); o.z = pk2(y[4], y[5]); o.w = pk2(y[6], y[7]); }
            *(v4u*)(acat + (size_t)row * 384 + 8 * lane) = o; }
    }
}

constexpr int SCAN_PF = 4;

typedef float f32x16s __attribute__((ext_vector_type(16)));
#define SL4(a, b, c, d, p, o0, o1, o2, o3) asm volatile("s_load_dwordx16 %0, %4, %5\n\ts_load_dwordx16 %1, %4, %6\n\ts_load_dwordx16 %2, %4, %7\n\ts_load_dwordx16 %3, %4, %8\n\ts_waitcnt lgkmcnt(0)" : "=&s"(a), "=&s"(b), "=&s"(c), "=&s"(d) : "s"(p), "i"(o0), "i"(o1), "i"(o2), "i"(o3) : "memory")
#define SL3(a, b, c, p, o0, o1, o2) asm volatile("s_load_dwordx16 %0, %3, %4\n\ts_load_dwordx16 %1, %3, %5\n\ts_load_dwordx16 %2, %3, %6\n\ts_waitcnt lgkmcnt(0)" : "=&s"(a), "=&s"(b), "=&s"(c) : "s"(p), "i"(o0), "i"(o1), "i"(o2) : "memory")
#define SL2(a, b, p, o0, o1) asm volatile("s_load_dwordx16 %0, %2, %3\n\ts_load_dwordx16 %1, %2, %4\n\ts_waitcnt lgkmcnt(0)" : "=&s"(a), "=&s"(b) : "s"(p), "i"(o0), "i"(o1) : "memory")
#define PR(v, p) ((f32x2){(v)[2 * (p)], (v)[2 * (p) + 1]})
#define SCAN_SA(S, o) ({ f32x16s k0_, k1_, k2_, k3_; SL4(k0_, k1_, k2_, k3_, o, 0, 64, 128, 192); f32x2 sa2_ = {0.f, 0.f}; \
    _Pragma("unroll") for (int p_ = 0; p_ < 8; ++p_) { sa2_ += S[p_] * PR(k0_, p_); sa2_ += S[8 + p_] * PR(k1_, p_); sa2_ += S[16 + p_] * PR(k2_, p_); sa2_ += S[24 + p_] * PR(k3_, p_); } -(sa2_.x + sa2_.y); })

__device__ __forceinline__ void scan_pass1(const Ctx&, unsigned char* ws, int rot) { const Ctx c = mk_ctx();
    const float* scanop = (const float*)(ws + WS_R + R_SCAN); const bf16* vbf = (const bf16*)(ws + WS_HA + HA_VBF); float* PL = (float*)(ws + WS_R + R_PL);
    const int lane = c.lane; float pfdummy = 0.f;
    if (c.wid >= 4) return;
    for (int task = (int)((blockIdx.x + (rot ? gridDim.x / 2 : 0)) % gridDim.x) * 4 + c.wid; task < 16 * (NCH - 1); task += gridDim.x * 4) {
        const int cc = task % (NCH - 1), chain = task / (NCH - 1);
        f32x2 SP[32], SLs[32];
#pragma unroll
        for (int j = 0; j < 32; ++j) { SP[j].x = (2 * j == lane) ? 1.f : 0.f; SP[j].y = (2 * j + 1 == lane) ? 1.f : 0.f; SLs[j] = (f32x2){0.f, 0.f}; }
        cfloat* ob = (cfloat*)(scanop + ((size_t)chain * SEQ + (size_t)cc * CHL) * 320);
        const float* og = scanop + ((size_t)chain * SEQ + (size_t)cc * CHL) * 320;
        const bf16* vp = vbf + ((size_t)chain * SEQ + (size_t)cc * CHL) * 64 + lane;
        f32x4 pfa = {0.f, 0.f, 0.f, 0.f}; unsigned short vnext = vp[0];
        for (int t = 0; t < CHL; ++t) { cfloat* o = ob + (size_t)t * 320;
            const unsigned short vcur = vnext; pfdummy += pfa[0];
            vnext = vp[(size_t)(t + 1) * 64];
            pfa = *(const f32x4*)(og + (size_t)(t + SCAN_PF) * 320 + lane * 4);
            float saP, saL;
            { f32x16s k0_, k1_, k2_, k3_; SL4(k0_, k1_, k2_, k3_, o, 0, 64, 128, 192); f32x2 a2 = {0.f, 0.f}, b2 = {0.f, 0.f};
#pragma unroll
              for (int p_ = 0; p_ < 8; ++p_) { a2 += SP[p_] * PR(k0_, p_); b2 += SLs[p_] * PR(k0_, p_); a2 += SP[8 + p_] * PR(k1_, p_); b2 += SLs[8 + p_] * PR(k1_, p_);
                  a2 += SP[16 + p_] * PR(k2_, p_); b2 += SLs[16 + p_] * PR(k2_, p_); a2 += SP[24 + p_] * PR(k3_, p_); b2 += SLs[24 + p_] * PR(k3_, p_); }
              saP = -(a2.x + a2.y); saL = -(b2.x + b2.y); }
            const f32x2 savP = {saP, saP}, savL = {saL, saL}; const float v = __builtin_bit_cast(float, (unsigned)vcur << 16); const f32x2 vv = {v, v};
#define P1_BLK(b) { f32x16s w_, a_, k_; SL3(w_, a_, k_, o, 256 + 64 * (b), 512 + 64 * (b), 768 + 64 * (b)); _Pragma("unroll") for (int p_ = 0; p_ < 8; ++p_) { \
                f32x2 s = SP[8 * (b) + p_] * PR(w_, p_); s += savP * PR(a_, p_); SP[8 * (b) + p_] = s; \
                f32x2 l = SLs[8 * (b) + p_] * PR(w_, p_); l += savL * PR(a_, p_); l += vv * PR(k_, p_); SLs[8 * (b) + p_] = l; } }
            P1_BLK(0) P1_BLK(1) P1_BLK(2) P1_BLK(3)
#undef P1_BLK
        }
        float* dst = PL + (((size_t)chain * NCH + cc) * 2) * 4096 + lane * 64;
#pragma unroll
        for (int j = 0; j < 16; ++j) { *(f32x4*)(dst + 4 * j) = (f32x4){SP[2 * j].x, SP[2 * j].y, SP[2 * j + 1].x, SP[2 * j + 1].y}; *(f32x4*)(dst + 4096 + 4 * j) = (f32x4){SLs[2 * j].x, SLs[2 * j].y, SLs[2 * j + 1].x, SLs[2 * j + 1].y}; }
    }
    if (pfdummy == 1.2345e-30f) PL[0] = pfdummy;
}
__device__ __forceinline__ void scan_pass2(const Ctx&, unsigned char* ws) { const Ctx c = mk_ctx();
    float* PL = (float*)(ws + WS_R + R_PL); const int lane = c.lane;
    const int xcd_ = blockIdx.x & 7, tt_ = (blockIdx.x >> 3) * 8 + c.wid;
    for (int task = (gridDim.x == 256) ? ((tt_ < 128) ? ((xcd_ + 8 * (tt_ >> 6)) * 64 + (tt_ & 63)) : 16 * 64) : c.gw; task < 16 * 64; task += (gridDim.x == 256) ? 16 * 64 : c.NGW) { const int chain = task >> 6, i = task & 63;
        float s = 0.f;
        for (int cc = 0; cc < NCH - 1; ++cc) { float* P = PL + (((size_t)chain * NCH + cc) * 2) * 4096; float* L = P + 4096 + i * 64;
            float a0 = L[lane], a1 = 0.f, a2 = 0.f, a3 = 0.f;
#pragma unroll
            for (int k = 0; k < 64; k += 4) { a0 += __shfl(s, k) * P[k * 64 + lane]; a1 += __shfl(s, k + 1) * P[(k + 1) * 64 + lane]; a2 += __shfl(s, k + 2) * P[(k + 2) * 64 + lane]; a3 += __shfl(s, k + 3) * P[(k + 3) * 64 + lane]; }
            s = (a0 + a1) + (a2 + a3); L[lane] = s; }
    }
}
__device__ __forceinline__ void scan_pass3(const Ctx&, const In& in, unsigned char* ws, int jl, int rot) { const Ctx c = mk_ctx();
    const float* scanop = (const float*)(ws + WS_R + R_SCAN); const bf16* vbf = (const bf16*)(ws + WS_HA + HA_VBF); const float* PL = (const float*)(ws + WS_R + R_PL);
    const bf16* gbuf = (const bf16*)(ws + WS_R + R_G); bf16* oc = (bf16*)(ws + WS_R + R_QK);
    const float* r_k = in[23] + (size_t)jl * 512; const float* ln_w = in[24] + (size_t)jl * 512; const float* ln_b = in[25] + (size_t)jl * 512;
    const int lane = c.lane; float* yl = (float*)(c.lds + c.wid * 4096); float pfdummy = 0.f;
    if (c.wid >= 4) return;
    for (int task = (int)((blockIdx.x + (rot ? gridDim.x / 2 : 0)) % gridDim.x) * 4 + c.wid; task < 16 * NCH; task += gridDim.x * 4) { const int chain = task / NCH, cc = task % NCH, b = chain >> 3, h = chain & 7;
        f32x2 S[32];
        if (cc == 0) {
#pragma unroll
            for (int j = 0; j < 32; ++j) S[j] = (f32x2){0.f, 0.f};
        } else { const float* src = PL + (((size_t)chain * NCH + cc - 1) * 2 + 1) * 4096 + lane * 64;
#pragma unroll
            for (int j = 0; j < 16; ++j) { const f32x4 v = *(const f32x4*)(src + 4 * j); S[2 * j] = (f32x2){v[0], v[1]}; S[2 * j + 1] = (f32x2){v[2], v[3]}; } }
        const size_t tb = (size_t)chain * SEQ + (size_t)cc * CHL;
        cfloat* ob = (cfloat*)(scanop + tb * 320); const bf16* vp = vbf + tb * 64 + lane; const float* og = scanop + tb * 320;
        f32x4 pfa = {0.f, 0.f, 0.f, 0.f}; float pfb = 0.f; unsigned short vnext = vp[0];
        for (int t = 0; t < CHL; ++t) { cfloat* o = ob + (size_t)t * 320;
            const unsigned short vcur = vnext; pfdummy += pfa[0] + pfb;
            vnext = vp[(size_t)(t + 1) * 64];
            pfa = *(const f32x4*)(og + (size_t)(t + SCAN_PF) * 320 + lane * 4); pfb = og[(size_t)(t + SCAN_PF) * 320 + 256 + lane];
            const float v = __builtin_bit_cast(float, (unsigned)vcur << 16); const f32x2 vv = {v, v};
            const float sa = SCAN_SA(S, o); const f32x2 sav = {sa, sa}; f32x2 y2 = {0.f, 0.f};
#define P3_BLK(b) { f32x16s w_, a_, k_, r_; SL4(w_, a_, k_, r_, o, 256 + 64 * (b), 512 + 64 * (b), 768 + 64 * (b), 1024 + 64 * (b)); _Pragma("unroll") for (int p_ = 0; p_ < 8; ++p_) { f32x2 s = S[8 * (b) + p_] * PR(w_, p_); s += sav * PR(a_, p_); s += vv * PR(k_, p_); S[8 * (b) + p_] = s; y2 += s * PR(r_, p_); } }
            P3_BLK(0) P3_BLK(1) P3_BLK(2) P3_BLK(3)
#undef P3_BLK
            yl[(t & 15) * 64 + lane] = y2.x + y2.y;
            if ((t & 15) == 15) {
                const int tau = lane >> 2, qd = lane & 3; const int tt = cc * CHL + (t - 15) + tau; const size_t row = (size_t)b * SEQ + tt;
                const float* yb = yl + tau * 64 + 16 * qd; const float* sb = scanop + ((size_t)chain * SEQ + tt) * 320 + 16 * qd;
                float y[16]; float sm = 0.f, bon = 0.f;
#pragma unroll
                for (int q = 0; q < 4; ++q) { const f32x4 yv = *(const f32x4*)(yb + 4 * q); const f32x4 rv = *(const f32x4*)(sb + 256 + 4 * q), kv = *(const f32x4*)(sb + 192 + 4 * q), rk = *(const f32x4*)(r_k + h * 64 + 16 * qd + 4 * q);
#pragma unroll
                    for (int e = 0; e < 4; ++e) { y[4 * q + e] = yv[e]; sm += yv[e]; bon += rv[e] * kv[e] * rk[e]; } }
                sm += __shfl_xor(sm, 1); sm += __shfl_xor(sm, 2); bon += __shfl_xor(bon, 1); bon += __shfl_xor(bon, 2);
                const float mean = sm * (1.f / 64.f); float vs = 0.f;
#pragma unroll
                for (int q = 0; q < 16; ++q) { const float d = y[q] - mean; vs += d * d; }
                vs += __shfl_xor(vs, 1); vs += __shfl_xor(vs, 2);
                const float rstd = rsqrtf(vs * (1.f / 64.f) + 64e-5f);
                const v4u vu0 = *(const v4u*)(vbf + ((size_t)chain * SEQ + tt) * 64 + 16 * qd), vu1 = *(const v4u*)(vbf + ((size_t)chain * SEQ + tt) * 64 + 16 * qd + 8);
                const v4u gu0 = *(const v4u*)(gbuf + row * 512 + h * 64 + 16 * qd), gu1 = *(const v4u*)(gbuf + row * 512 + h * 64 + 16 * qd + 8);
                float out[16];
#pragma unroll
                for (int q = 0; q < 8; ++q) { const unsigned vw = q < 4 ? vu0[q] : vu1[q - 4], gw_ = q < 4 ? gu0[q] : gu1[q - 4]; const int cidx = h * 64 + 16 * qd + 2 * q;
                    out[2 * q] = ((y[2 * q] - mean) * rstd * ln_w[cidx] + ln_b[cidx] + bon * bflo(vw)) * bflo(gw_);
                    out[2 * q + 1] = ((y[2 * q + 1] - mean) * rstd * ln_w[cidx + 1] + ln_b[cidx + 1] + bon * bfhi(vw)) * bfhi(gw_); }
                v4u o0, o1; o0.x = pk2(out[0], out[1]); o0.y = pk2(out[2], out[3]); o0.z = pk2(out[4], out[5]); o0.w = pk2(out[6], out[7]); o1.x = pk2(out[8], out[9]); o1.y = pk2(out[10], out[11]); o1.z = pk2(out[12], out[13]); o1.w = pk2(out[14], out[15]);
                bf16* op = oc + row * 1024 + 512 + h * 64 + 16 * qd; *(v4u*)op = o0; *(v4u*)(op + 8) = o1;
            }
        }
    }
    if (pfdummy == 1.2345e-30f) yl[0] = pfdummy;
}

constexpr int KLD = 104, VLD = 68, KTILE_E = 64 * KLD, VTILE_E = 64 * VLD;
__device__ __forceinline__ void mla_attn_phase(const Ctx&, unsigned char* ws) { const Ctx c = mk_ctx();
    const bf16* q = (const bf16*)(ws + WS_R + R_Q); const bf16* kn = (const bf16*)(ws + WS_R + R_KN); const bf16* krope = (const bf16*)(ws + WS_R + R_KROPE); const bf16* vt = (const bf16*)(ws + WS_R + R_VT); bf16* o = (bf16*)(ws + WS_R + R_O);
    bf16* Kl = (bf16*)c.lds; bf16* Vl = Kl + 2 * KTILE_E;
    const int tid = c.tid, lane = c.lane, wid = c.wid, r = lane & 31, hi = lane >> 5;
    const int kc0_row = tid / 12, kc0_part = tid % 12, kc1_row = (512 + tid) / 12, kc1_part = (512 + tid) % 12, vd = tid >> 3, vpart = tid & 7;
    for (int uu = blockIdx.x; uu < 1024; uu += gridDim.x) {
        const int v0_ = uu & 255, v = (gridDim.x == 256) ? ((v0_ & 7) * 32 + (v0_ >> 3)) : v0_;
        const int ii = uu >> 8, bh = v >> 3, s8 = v & 7, qb = ii == 0 ? s8 : (ii == 1 ? 15 - s8 : (ii == 2 ? 16 + s8 : 31 - s8));
        const int b = bh >> 4, h = bh & 15, Q0 = qb * 256, qw0 = Q0 + 32 * wid; const size_t rowbase = (size_t)b * SEQ;
        bf16x8 qr[6];
#pragma unroll
        for (int s = 0; s < 6; ++s) qr[s] = *(const bf16x8*)(q + (rowbase + qw0 + r) * 1536 + h * 96 + 16 * s + 8 * hi);
        const int ntiles = (Q0 + 256) / 64, my_last = (qw0 + 31) / 64;
        f32x16 oa[2]; oa[0] = f32x16{}; oa[1] = f32x16{}; float mrun = -INFINITY, lrun = 0.f;
        v4u kreg0, kreg1 = {0u, 0u, 0u, 0u}, vreg;
#define MLA_LOAD(j) do { const int t0_ = (j) * 64; \
            kreg0 = kc0_part < 8 ? *(const v4u*)(kn + (rowbase + t0_ + kc0_row) * 1024 + h * 64 + kc0_part * 8) : *(const v4u*)(krope + (rowbase + t0_ + kc0_row) * 32 + (kc0_part - 8) * 8); \
            if (tid < 256) kreg1 = kc1_part < 8 ? *(const v4u*)(kn + (rowbase + t0_ + kc1_row) * 1024 + h * 64 + kc1_part * 8) : *(const v4u*)(krope + (rowbase + t0_ + kc1_row) * 32 + (kc1_part - 8) * 8); \
            vreg = *(const v4u*)(vt + ((size_t)(bh * 64 + vd)) * SEQ + t0_ + vpart * 8); } while (0)
        MLA_LOAD(0);
        for (int j = 0; j < ntiles; ++j) { bf16* Kb = Kl + (j & 1) * KTILE_E; bf16* Vb = Vl + (j & 1) * VTILE_E;
            *(v4u*)(Kb + kc0_row * KLD + kc0_part * 8) = kreg0; if (tid < 256) *(v4u*)(Kb + kc1_row * KLD + kc1_part * 8) = kreg1;
            *(v2u*)(Vb + vd * VLD + vpart * 8) = (v2u){vreg.x, vreg.y}; *(v2u*)(Vb + vd * VLD + vpart * 8 + 4) = (v2u){vreg.z, vreg.w};
            __syncthreads();
            if (j + 1 < ntiles) MLA_LOAD(j + 1);
            if (j <= my_last) {
                f32x16 p0 = f32x16{}, p1 = f32x16{};
#pragma unroll
                for (int s = 0; s < 6; ++s) { const bf16x8 a0 = *(const bf16x8*)(Kb + r * KLD + 16 * s + 8 * hi), a1 = *(const bf16x8*)(Kb + (r + 32) * KLD + 16 * s + 8 * hi); p0 = MFMA32(a0, qr[s], p0); p1 = MFMA32(a1, qr[s], p1); }
                if (64 * j + 63 > qw0) { const int qq = qw0 + r - 64 * j;
#pragma unroll
                    for (int i = 0; i < 16; ++i) { const int kr_ = crow(i, hi); if (kr_ > qq) p0[i] = -INFINITY; if (kr_ + 32 > qq) p1[i] = -INFINITY; } }
                float mx = fmaxf(p0[0], p1[0]);
#pragma unroll
                for (int i = 1; i < 16; ++i) mx = fmaxf(mx, fmaxf(p0[i], p1[i]));
                mx = fmaxf(mx, __shfl_xor(mx, 32));
                const float mnew = fmaxf(mrun, mx), alpha = __builtin_amdgcn_exp2f(mrun - mnew); const bool grow = !__all(mx <= mrun); mrun = mnew; float ls = 0.f;
#pragma unroll
                for (int i = 0; i < 16; ++i) { p0[i] = __builtin_amdgcn_exp2f(p0[i] - mnew); p1[i] = __builtin_amdgcn_exp2f(p1[i] - mnew); ls += p0[i] + p1[i]; }
                lrun = lrun * alpha + ls;
#pragma unroll
                for (int i = 0; i < 16; ++i) if (grow) { oa[0][i] *= alpha; oa[1][i] *= alpha; }
                bf16x8 pa[4]; pa[0] = pack8(p0, 0); pa[1] = pack8(p0, 1); pa[2] = pack8(p1, 0); pa[3] = pack8(p1, 1);
#pragma unroll
                for (int db = 0; db < 2; ++db)
#pragma unroll
                    for (int ks = 0; ks < 4; ++ks) { const bf16* vp = Vb + (32 * db + r) * VLD + 16 * ks + 4 * hi; oa[db] = MFMA32(cat4(*(const v2u*)vp, *(const v2u*)(vp + 8)), pa[ks], oa[db]); }
            }
        }
#undef MLA_LOAD
        lrun += __shfl_xor(lrun, 32); const float il = 1.0f / lrun;
        bf16* op = o + (rowbase + qw0 + r) * 1024 + h * 64;
#pragma unroll
        for (int db = 0; db < 2; ++db)
#pragma unroll
            for (int g = 0; g < 4; ++g) *(v2u*)(op + 32 * db + 8 * g + 4 * hi) = pk4((f32x4){oa[db][4 * g] * il, oa[db][4 * g + 1] * il, oa[db][4 * g + 2] * il, oa[db][4 * g + 3] * il});
        __syncthreads();
    }
}
#ifndef REP_PHASE
#define REP_PHASE -1
#endif
#define REPLOOP(id) int nrep_ = (REP_PHASE == (id)) ? 2 : 1; asm volatile("" : "+s"(nrep_)); for (int rep_ = 0; rep_ < nrep_; ++rep_)
#ifndef DUP_MLA
#define DUP_MLA 0
#endif
#ifndef DUP_R1
#define DUP_R1 0
#endif
#ifndef DUP_R3
#define DUP_R3 0
#endif
#ifndef DUP_G45
#define DUP_G45 0
#endif
#ifndef DUP_PREP
#define DUP_PREP 0
#endif
#ifndef DUP_SYNC
#define DUP_SYNC 0
#endif
#ifndef STOP_L
#define STOP_L 99
#endif
#ifndef STOP_S
#define STOP_S 99
#endif
#define PH(s) (layer < STOP_L || (layer == STOP_L && (s) <= STOP_S))
#ifndef PH_SB
#define PH_SB 1
#endif
#ifndef PH_PREP
#define PH_PREP 1
#endif
#ifndef PH_S1
#define PH_S1 1
#endif
#ifndef PH_S2
#define PH_S2 1
#endif
#ifndef PH_S3
#define PH_S3 1
#endif
#ifndef PH_MLA
#define PH_MLA 1
#endif
#ifndef PH_GEMM
#define PH_GEMM 1
#endif
#ifndef PH_CONV
#define PH_CONV 1
#endif

#define RLX_AGENT __ATOMIC_RELAXED, __HIP_MEMORY_SCOPE_AGENT
#define XB_TMO      128
#define XB_XCNT(j)  (256  + 64 * (j))
#define XB_XSUB(j)  (1280 + 64 * (j))
#define XB_XGEN(j)  (2304 + 64 * (j))
#define XB_TOP      3328
#define XB_TOPGEN   3392
#define XCD_BAR_WORDS 3456
#define XB_SPIN_CAP (1u << 18)

__device__ __forceinline__ unsigned xb_ld(unsigned* p)              { return __hip_atomic_load(p, __ATOMIC_RELAXED, __HIP_MEMORY_SCOPE_AGENT); }
__device__ __forceinline__ unsigned xb_add(unsigned* p, unsigned v) { return __hip_atomic_fetch_add(p, v, __ATOMIC_RELAXED, __HIP_MEMORY_SCOPE_AGENT); }
__device__ __forceinline__ unsigned xb_xcc_id() { return (unsigned)__builtin_amdgcn_s_getreg((3 << 11) | 20) & 0xFu; }
#define XB_SPIN(cond, bar) do { unsigned _sp = 0; while (cond) { __builtin_amdgcn_s_sleep(1); \
    if ((++_sp & 255u) == 0u) { if (xb_ld(&(bar)[XB_TMO])) break; if (_sp > XB_SPIN_CAP) { atomicAdd(&(bar)[XB_TMO], 1u); break; } } } } while (0)

struct XcdBarrier {
    unsigned* bar; unsigned x;
    volatile LAS unsigned* st;
};

__device__ __forceinline__ XcdBarrier xcd_barrier_post(unsigned* bar, volatile LAS unsigned* st) {
    XcdBarrier b; b.bar = bar; b.x = xb_xcc_id(); b.st = st;
    if (threadIdx.x == 0) (void)xb_add(&bar[XB_XCNT(b.x)], 1u);
    return b;
}
__device__ __forceinline__ void xcd_barrier_complete(unsigned* bar, unsigned x, unsigned& nloc, unsigned& nx) {
    const unsigned G = gridDim.x * gridDim.y * gridDim.z;
    unsigned sum, cnt, mine, sp = 0u;
    for (;;) {
        sum = 0u; cnt = 0u; mine = 0u;
#pragma unroll
        for (unsigned j = 0; j < 16; ++j) { const unsigned c = xb_ld(&bar[XB_XCNT(j)]); sum += c; cnt += (c > 0u) ? 1u : 0u; mine = (j == x) ? c : mine; }
        if (sum == G) break;
        __builtin_amdgcn_s_sleep(1);
        if ((++sp & 255u) == 0u) { if (xb_ld(&bar[XB_TMO])) break; if (sp > XB_SPIN_CAP) { atomicAdd(&bar[XB_TMO], 1u); break; } }
    }
    nloc = mine > 0u ? mine : 1u; nx = cnt > 0u ? cnt : 1u;
}

__device__ __forceinline__ void xcd_barrier(const XcdBarrier& b) {
    asm volatile("s_waitcnt vmcnt(0)" ::: "memory");
    __syncthreads();
    if (threadIdx.x == 0) {
        unsigned* bar = b.bar;
        __builtin_amdgcn_s_waitcnt(0);
        unsigned nloc = b.st[0], nx = b.st[1];
        if (nloc == 0u) { xcd_barrier_complete(bar, b.x, nloc, nx); b.st[0] = nloc; b.st[1] = nx; }
        const unsigned old = xb_add(&bar[XB_XSUB(b.x)], 1u);
        const unsigned gen = old / nloc;
        if (old + 1u == (gen + 1u) * nloc) {
            __builtin_amdgcn_fence(__ATOMIC_RELEASE, "agent");
            asm volatile("s_waitcnt vmcnt(0)" ::: "memory");
            const unsigned og = xb_add(&bar[XB_TOP], 1u);
            const unsigned tg = og / nx;
            if (og + 1u == (tg + 1u) * nx) xb_add(&bar[XB_TOPGEN], 1u);
            else XB_SPIN(xb_ld(&bar[XB_TOPGEN]) == tg, bar);
            __builtin_amdgcn_fence(__ATOMIC_ACQUIRE, "agent");
            xb_add(&bar[XB_XGEN(b.x)], 1u);
            asm volatile("s_waitcnt vmcnt(0)" ::: "memory");
        } else {
            XB_SPIN(xb_ld(&bar[XB_XGEN(b.x)]) == gen, bar);
            __builtin_amdgcn_fence(__ATOMIC_ACQUIRE, "agent");
            asm volatile("s_waitcnt vmcnt(0)" ::: "memory");
        }
    }
    __syncthreads();
}

constexpr int LDS_BYTES = 131072 + 512;
struct Args { const float* in[33]; float* out; unsigned char* ws; };

__global__ void __launch_bounds__(512, 2) mega_fwd(Args a) {
    unsigned char* lds = g_lds;
    Ctx c{};
    LAS unsigned char* ldsl = (LAS unsigned char*)lds;
    In in;
    if (threadIdx.x < 33) ((unsigned long long*)(lds + 131072))[threadIdx.x] = (unsigned long long)a.in[threadIdx.x];
    if (threadIdx.x == 33) ((unsigned long long*)(lds + 131072))[33] = (unsigned long long)a.out;
    if (threadIdx.x == 34) ((unsigned long long*)(lds + 131072))[34] = (unsigned long long)a.ws;
    if (threadIdx.x == 35) { ((unsigned*)(lds + 131072 + 384))[0] = 0u; ((unsigned*)(lds + 131072 + 384))[1] = 0u; }
    if (threadIdx.x == 0) (void)xb_add(&((unsigned*)a.ws)[XB_XCNT(xb_xcc_id())], 1u);
    __syncthreads();
#define h ((float*)in[33])
#define ws ((unsigned char*)in[34])
#define rss ((float*)(ws + WS_RSS))
#define tab ((const float*)(ws + WS_ROPE))
#define hA ((bf16*)(ws + WS_HA))
#define hA2 ((bf16*)(ws + WS_R + R_HA2))
#define W (ws + WS_W)
#define R (ws + WS_R)
#define SYNC() do { asm volatile("s_waitcnt vmcnt(0) lgkmcnt(0)" ::: "memory"); XcdBarrier xb_; xb_.bar = (unsigned*)P_WS; xb_.x = xb_xcc_id(); xb_.st = (volatile LAS unsigned*)(LAS unsigned char*)(g_lds + PTAB_OFF + 384); xcd_barrier(xb_); } while (0)

    phase0(c, in, h, ws);
#if PH_CONV
    conv_mixer(c, in, ws, 0); conv_ffn(c, in, ws, 0); conv_p(c, in, ws, 0);
#endif
    SYNC();

    for (int layer = 0; layer < 4; ++layer) {
        const int jl = layer >> 1;
        if ((layer & 1) == 0) {
{ REPLOOP(0) {             if (PH(0)) { { EpiHybIn e{layer}; run_gemm<0>(ldsl, hA2, (const bf16*)(W + W_HYBIN), T, 3584, 1024, e); } } if (rep_ + 1 < nrep_) SYNC(); } }
            if (layer > 0) conv_ffn(c, in, ws, layer);
            SYNC();
#if PH_PREP
{ REPLOOP(6) {             if (PH(1)) { rw_prep_phase(c, in, ws, jl); } if (rep_ + 1 < nrep_) SYNC(); } }
#if DUP_PREP
            SYNC(); rw_prep_phase(c, in, ws, jl);
#endif
#endif
            SYNC();
            if (PH(2)) { { EpiLora e{layer}; run_gemm<1>(ldsl, (const bf16*)(ws + WS_HA + HA_ACAT), (const bf16*)(W + W_LORA), T, 1536, 384, e); } }
            SYNC();
#if PH_S1
{ REPLOOP(1) {             if (PH(3)) { if (__builtin_amdgcn_readfirstlane(threadIdx.x >> 6) < 4) scan_pass1(c, ws, jl); else sb_attn_phase(c, (bf16*)(R + R_QK), (const bf16*)(R + R_VTSB)); } if (rep_ + 1 < nrep_) SYNC(); } }
#if DUP_R1
            SYNC(); scan_pass1(c, ws, jl);
#endif
#endif
            SYNC();
#if PH_S2
            if (PH(4)) { scan_pass2(c, ws); }
#endif
            SYNC();
#if PH_S3
{ REPLOOP(2) {             if (PH(5)) { scan_pass3(c, in, ws, jl, jl); } if (rep_ + 1 < nrep_) SYNC(); } }
#if DUP_R3
            SYNC(); scan_pass3(c, in, ws, jl, jl);
#endif
#endif
            SYNC();
            if (PH(6)) { { EpiResid e{layer, 0}; run_gemm<2>(ldsl, (const bf16*)(R + R_QK), (const bf16*)(W + W_HYBOUT), T, 1024, 1024, e); } }
            SYNC();
        } else {
            if (PH(0)) { EpiMlaDown e{layer};
              run_gemm<3>(ldsl, hA2, (const bf16*)(W + W_DOWN), T, 768, 1024, e); }
            conv_ffn(c, in, ws, layer);
            SYNC();
            if (PH(1)) { { EpiUq e{layer}; run_gemm<4>(ldsl, (const bf16*)(R + R_CQ), (const bf16*)(W + W_UQ), T, 1536, 384, e); } }
            if (PH(1)) { { EpiUkv e{layer}; run_gemm<5>(ldsl, (const bf16*)(R + R_CKV), (const bf16*)(W + W_UKV), T, 2048, 256, e); } }
            SYNC();
#if PH_MLA
{ REPLOOP(3) {             if (PH(2)) { mla_attn_phase(c, ws); } if (rep_ + 1 < nrep_) SYNC(); } }
#if DUP_MLA
            SYNC(); mla_attn_phase(c, ws);
#endif
#endif
            SYNC();
            if (PH(6)) { { EpiResid e{layer, 0}; run_gemm<6>(ldsl, (const bf16*)(R + R_O), (const bf16*)(W + W_WO), T, 1024, 1024, e); } }
            SYNC();
        }
{ REPLOOP(4) {         if (PH(7)) { { EpiFfnG e{layer}; run_gemm<7>(ldsl, hA, (const bf16*)(W + W_FFNIN) + (size_t)FFN * 1024, T, FFN, 1024, e); } } if (rep_ + 1 < nrep_) SYNC(); } }
{ REPLOOP(7) {         if (PH(7)) { { EpiPe e{layer}; run_gemm<8>(ldsl, (const bf16*)(ws + WS_PB), (const bf16*)(W + W_PLEP), T, 1024, 256, e); } } if (rep_ + 1 < nrep_) SYNC(); } }
#if PH_CONV
        if (PH(7)) { if (layer < 3) conv_mixer(c, in, ws, layer + 1); }
#endif
        SYNC();
{ REPLOOP(5) {         if (PH(8)) { { EpiFfnU e{layer}; run_gemm<9>(ldsl, hA, (const bf16*)(W + W_FFNIN), T, FFN, 1024, e); } } if (rep_ + 1 < nrep_) SYNC(); } }
#if DUP_G45
        SYNC(); { EpiFfnG e{layer}; run_gemm<7>(ldsl, hA, (const bf16*)(W + W_FFNIN) + (size_t)FFN * 1024, T, FFN, 1024, e); }
        SYNC(); { EpiFfnU e{layer}; run_gemm<9>(ldsl, hA, (const bf16*)(W + W_FFNIN), T, FFN, 1024, e); }
#endif
#if DUP_SYNC
        SYNC(); SYNC(); SYNC(); SYNC(); SYNC(); SYNC(); SYNC(); SYNC(); SYNC(); SYNC();
#endif
        SYNC();
        if (PH(9)) { { EpiResid e{layer, 1}; run_gemm<10>(ldsl, (const bf16*)(R + R_ACT), (const bf16*)(W + W_FFNOUT), T, 1024, FFN, e); } }
#if PH_CONV
        if (PH(9)) { if (layer < 3) conv_p(c, in, ws, layer + 1); }
#endif
        SYNC();
        if (PH(10)) { EpiPleGate e{layer};
          run_gemm<11>(ldsl, hA, (const bf16*)(W + W_PLEG), T, 1024, 1024, e); }
        SYNC();
    }
    phase_final(c, in, h, ws);
    if (gridDim.x == 0x7fffffffu) cg::this_grid().sync();
#undef SYNC
#undef h
#undef ws
#undef rss
#undef tab
#undef hA
#undef hA2
#undef W
#undef R
}

extern "C" void kernel_launch(void* const* d_in, const int* in_sizes, int n_in, void* d_out, int out_size, void* d_ws, size_t ws_size, hipStream_t stream) {
    static int grid_blocks = 0;
    if (grid_blocks == 0) {
        if (n_in != 33 || out_size != T * D || ws_size < WS_NEED) { fprintf(stderr, "kernel_launch: unexpected problem (n_in %d out %d ws %zu)\n", n_in, out_size, ws_size); grid_blocks = -1; return; }
        int dev = 0, cus = 0, per_cu = 0;
        hipGetDevice(&dev); hipDeviceGetAttribute(&cus, hipDeviceAttributeMultiprocessorCount, dev);
        hipFuncSetAttribute((const void*)mega_fwd, hipFuncAttributeMaxDynamicSharedMemorySize, LDS_BYTES);
        hipOccupancyMaxActiveBlocksPerMultiprocessor(&per_cu, (const void*)mega_fwd, 512, LDS_BYTES);
        if (per_cu < 1) per_cu = 1;
        (void)hipGetLastError();
        grid_blocks = cus * per_cu;
    }
    if (grid_blocks < 0) return;
    if (hipMemsetAsync(d_ws, 0, 16384, stream) != hipSuccess) { fprintf(stderr, "memset failed\n"); return; }
    Args a{};
    for (int i = 0; i < 33; ++i) a.in[i] = (const float*)d_in[i];
    a.out = (float*)d_out; a.ws = (unsigned char*)d_ws;
    void* args[] = {&a};
    hipError_t e = hipLaunchCooperativeKernel((const void*)mega_fwd, dim3(grid_blocks), dim3(512), args, LDS_BYTES, stream);
    if (e != hipSuccess) fprintf(stderr, "cooperative launch failed: %s (grid %d)\n", hipGetErrorString(e), grid_blocks);
}
```

```cpp
#include <hip/hip_runtime.h>
#include <hip/hip_cooperative_groups.h>
#include <cstdio>
#include <cstdint>
namespace cg = cooperative_groups;
namespace pg8 {
#define PG8_LAS __attribute__((address_space(3)))
typedef unsigned short bf16_t;
typedef short bf16x8 __attribute__((ext_vector_type(8)));
typedef float f32x4 __attribute__((ext_vector_type(4)));
typedef unsigned u32x4 __attribute__((ext_vector_type(4)));
constexpr int BM = 256, BK = 64, HALF = 128, HTB = HALF * BK * 2  , STAGE_BYTES = 8 * HTB, NXCD = 8, WGM = 8;

__host__ __device__ __forceinline__ int lds_byte(int r, int c) { const int st = (r >> 4) * 2 + (c >> 5), rr = r & 15, cc = c & 31, ob = rr * 64 + cc * 2; return st * 1024 + (ob ^ (((ob >> 9) & 1) << 5)); }
__host__ __device__ __forceinline__ void stage_rc(int b, int& R, int& C) { const int st = b / 1024, sb = b % 1024, swz = sb ^ (((sb >> 9) & 1) << 5); R = (st >> 1) * 16 + swz / 64; C = (st & 1) * 32 + (swz % 64) / 2; }
__host__ __device__ __forceinline__ int perm32(int rho) { const int n = rho >> 4, i = rho & 15; return 8 * (i >> 2) + 4 * n + (i & 3); }

struct Unit { int pm, pn; };
struct Gemm { const bf16_t* A; const bf16_t* Bt; int M, N, K; };

struct StaticOrder {
    int nM, nN, nwg, G, c;
    __host__ __device__ void init(int M, int N, int G_, int c_) { nM = M / BM; nN = N / BM; nwg = nM * nN; G = G_; c = c_; }
    __host__ __device__ bool next(int i, Unit& u) const {
        const long L = (long)i * G + c; if (L >= nwg) return false;
        int wgid = (int)L; { const int q = nwg / NXCD, r = nwg % NXCD, xcd = wgid % NXCD, off = wgid / NXCD; wgid = (xcd < r ? xcd * (q + 1) : r * (q + 1) + (xcd - r) * q) + off; }
        const int nig = WGM * nN, gid = wgid / nig, fm = gid * WGM, gsz = (nM - fm) < WGM ? (nM - fm) : WGM;
        u.pm = fm + ((wgid % nig) % gsz); u.pn = (wgid % nig) / gsz; return true;
    }
    __device__ __forceinline__ void a_ready(const Unit&) const {}
    __device__ __forceinline__ void done(const Unit&) const {}
};

__device__ __forceinline__ unsigned cvt_pk_bf16(float lo, float hi) { unsigned r; asm volatile("v_cvt_pk_bf16_f32 %0, %1, %2" : "=v"(r) : "v"(lo), "v"(hi)); return r; }
typedef float f32x2 __attribute__((ext_vector_type(2)));
__device__ __forceinline__ f32x2 gelu_pk(f32x2 v) {
    const f32x2 av = __builtin_elementwise_abs(v), d = av * 0.2316418882f + 1.0f;
    f32x2 t; t.x = __builtin_amdgcn_rcpf(d.x); t.y = __builtin_amdgcn_rcpf(d.y);
    f32x2 q = t * 0.5307027145f + (-0.7265760135f); q = q * t + 0.7107068705f; q = q * t + (-0.142248368f); q = q * t + 0.127414796f; q = q * t;
    const f32x2 s = (v * v) * (-0.72134752044f);
    f32x2 e; e.x = __builtin_amdgcn_exp2f(s.x); e.y = __builtin_amdgcn_exp2f(s.y);
    const f32x2 m = v * (q * e), r = v - m;
    f32x2 o; o.x = v.x < 0.f ? m.x : r.x; o.y = v.y < 0.f ? m.y : r.y; return o;
}
template <class Epi, class Sched, bool ALIGN_EPI = false, bool SP2 = false>
__device__ __forceinline__ void gemm_phase(PG8_LAS unsigned char* lds, const Gemm g, const Sched& S, const Epi& E) {
    const int tid = threadIdx.x, wid = __builtin_amdgcn_readfirstlane(tid >> 6), lane = tid & 63, wr = wid >> 2, wc = wid & 3, fr = lane & 15, fq = lane >> 4;
    const int K = g.K, nt = K / BK;
    unsigned voffA[2], voffB[2];
#pragma unroll
    for (int i = 0; i < 2; ++i) { int R, C; stage_rc(tid * 16 + i * 8192, R, C); const int Rb = Epi::PERM ? ((R & ~31) + perm32(R & 31)) : R;
        voffA[i] = (unsigned)(R * K + C) * 2u; voffB[i] = (unsigned)(Rb * K + C) * 2u; }
    const size_t kstep = (size_t)(BK * 2);
    const size_t hstep = (size_t)HALF * K * 2;
    const size_t tstep = 2 * hstep;
    const unsigned ldsw = (unsigned)wid * 1024u;
    const int aoff = lds_byte(wr * 64 + fr, fq * 8), boff = lds_byte(wc * 32 + fr, fq * 8);
#define PG8_SA(b, h) (((b) * 2 + (h)) * HTB)
#define PG8_SB(b, h) ((4 + (b) * 2 + (h)) * HTB)
#define PG8_STAGE(bufoff, gbase, voff) do { _Pragma("unroll") for (int _i = 0; _i < 2; ++_i) \
        __builtin_amdgcn_global_load_lds((const unsigned*)((const char*)(gbase) + (voff)[_i]), (PG8_LAS unsigned*)(lds + (bufoff) + ldsw + _i * 8192), 16, 0, 0); } while (0)
#define PG8_LDA(dst, b, h) do { _Pragma("unroll") for (int m = 0; m < 4; ++m) _Pragma("unroll") for (int k = 0; k < 2; ++k) dst[m][k] = *(const PG8_LAS bf16x8*)(lds + PG8_SA(b, h) + aoff + m * 2048 + k * 1024); } while (0)
#define PG8_LDB(dst, b, h) do { _Pragma("unroll") for (int n = 0; n < 2; ++n) _Pragma("unroll") for (int k = 0; k < 2; ++k) dst[n][k] = *(const PG8_LAS bf16x8*)(lds + PG8_SB(b, h) + boff + n * 2048 + k * 1024); } while (0)
#define PG8_MMA(ai, bj, At, Bt) do { __builtin_amdgcn_s_setprio(1); _Pragma("unroll") for (int m = 0; m < 4; ++m) _Pragma("unroll") for (int n = 0; n < 2; ++n) _Pragma("unroll") for (int k = 0; k < 2; ++k) \
        acc[ai][bj][m][n] = __builtin_amdgcn_mfma_f32_16x16x32_bf16(Bt[n][k], At[m][k], acc[ai][bj][m][n], 0, 0, 0); __builtin_amdgcn_s_setprio(0); } while (0)
#define PG8_WAIT_V(n) asm volatile("s_waitcnt vmcnt(" #n ")" ::: "memory")
#define PG8_WAIT_L(n) asm volatile("s_waitcnt lgkmcnt(" #n ")" ::: "memory")
#define PG8_BAR __builtin_amdgcn_s_barrier()
#define PG8_SCHED __builtin_amdgcn_sched_barrier(0)
    Unit cur, nxt; int ui = 0;
    if (!S.next(0, cur)) return;
    f32x4 acc[2][2][4][2];
#pragma unroll
    for (int a = 0; a < 2; ++a)
#pragma unroll
        for (int b = 0; b < 2; ++b)
#pragma unroll
            for (int m = 0; m < 4; ++m)
#pragma unroll
                for (int n = 0; n < 2; ++n) acc[a][b][m][n] = (f32x4){0.f, 0.f, 0.f, 0.f};
    bf16x8 At[4][2], B0[2][2], B1[2][2];
    const char* cA = (const char*)g.A + (size_t)cur.pm * tstep; const char* cB = (const char*)g.Bt + (size_t)cur.pn * tstep;
    S.a_ready(cur);
    if constexpr (SP2) {
        PG8_STAGE(PG8_SB(0, 0), cB, voffB); PG8_STAGE(PG8_SB(0, 1), cB + hstep, voffB); PG8_STAGE(PG8_SA(0, 0), cA, voffA); PG8_STAGE(PG8_SA(0, 1), cA + hstep, voffA);
        if (wr == 1) PG8_BAR;
        PG8_WAIT_V(2); PG8_BAR;
        PG8_STAGE(PG8_SB(1, 0), cB + kstep, voffB); PG8_STAGE(PG8_SA(1, 0), cA + kstep, voffA); PG8_STAGE(PG8_SB(1, 1), cB + hstep + kstep, voffB);
        PG8_WAIT_V(6); PG8_BAR;
    } else {
        PG8_STAGE(PG8_SB(0, 0), cB, voffB); PG8_STAGE(PG8_SA(0, 0), cA, voffA); PG8_STAGE(PG8_SB(0, 1), cB + hstep, voffB); PG8_STAGE(PG8_SA(0, 1), cA + hstep, voffA);
        if (wr == 1) PG8_BAR;
        PG8_WAIT_V(4); PG8_BAR;
        PG8_STAGE(PG8_SB(1, 0), cB + kstep, voffB); PG8_STAGE(PG8_SA(1, 0), cA + kstep, voffA); PG8_STAGE(PG8_SB(1, 1), cB + hstep + kstep, voffB);
        PG8_WAIT_V(6); PG8_BAR;
    }
    for (;;) {
        const bool has_next = S.next(ui + 1, nxt);
        const char* nA = has_next ? (const char*)g.A + (size_t)nxt.pm * tstep : cA; const char* nB = has_next ? (const char*)g.Bt + (size_t)nxt.pn * tstep : cB;
        for (int t = 0; t < nt; t += 2) {
            const bool last = (t == nt - 2);
            const char* a1 = cA + (size_t)(t + 1) * kstep;
            const char* a2 = last ? nA : cA + (size_t)(t + 2) * kstep; const char* b2 = last ? nB : cB + (size_t)(t + 2) * kstep;
            const char* a3 = a2 + kstep; const char* b3 = b2 + kstep;
            if (last && has_next) S.a_ready(nxt);
            if constexpr (SP2) {
            PG8_LDB(B0, 0, 0); PG8_LDB(B1, 0, 1); PG8_SCHED; PG8_LDA(At, 0, 0); PG8_STAGE(PG8_SA(1, 1), a1 + hstep, voffA);
            PG8_WAIT_V(8); PG8_WAIT_L(0); PG8_BAR; PG8_MMA(0, 0, At, B0); PG8_MMA(0, 1, At, B1); PG8_BAR; PG8_SCHED;
            PG8_LDA(At, 0, 1); PG8_STAGE(PG8_SB(0, 0), b2, voffB); PG8_STAGE(PG8_SB(0, 1), b2 + hstep, voffB); PG8_STAGE(PG8_SA(0, 0), a2, voffA);
            PG8_WAIT_V(8); PG8_WAIT_L(0); PG8_BAR; PG8_MMA(1, 0, At, B0); PG8_MMA(1, 1, At, B1); PG8_BAR; PG8_SCHED;
            PG8_LDB(B0, 1, 0); PG8_LDB(B1, 1, 1); PG8_SCHED; PG8_LDA(At, 1, 0); PG8_STAGE(PG8_SA(0, 1), a2 + hstep, voffA);
            PG8_WAIT_V(8); PG8_WAIT_L(0); PG8_BAR; PG8_MMA(0, 0, At, B0); PG8_MMA(0, 1, At, B1); PG8_BAR; PG8_SCHED;
            PG8_LDA(At, 1, 1); PG8_STAGE(PG8_SB(1, 0), b3, voffB); PG8_STAGE(PG8_SB(1, 1), b3 + hstep, voffB); PG8_STAGE(PG8_SA(1, 0), a3, voffA);
            PG8_WAIT_V(8); PG8_WAIT_L(0); PG8_BAR; PG8_MMA(1, 0, At, B0); PG8_MMA(1, 1, At, B1); PG8_BAR; PG8_SCHED;
            } else {
            PG8_LDB(B0, 0, 0); PG8_SCHED; PG8_LDA(At, 0, 0); PG8_STAGE(PG8_SA(1, 1), a1 + hstep, voffA);
            PG8_WAIT_L(8); PG8_BAR; PG8_WAIT_L(0); PG8_MMA(0, 0, At, B0); PG8_BAR; PG8_SCHED;
            PG8_LDB(B1, 0, 1); PG8_STAGE(PG8_SB(0, 0), b2, voffB);
            PG8_BAR; PG8_WAIT_L(0); PG8_MMA(0, 1, At, B1); PG8_BAR;
            PG8_LDA(At, 0, 1); PG8_STAGE(PG8_SA(0, 0), a2, voffA);
            PG8_BAR; PG8_WAIT_L(0); PG8_MMA(1, 0, At, B0); PG8_BAR; PG8_SCHED;
            PG8_STAGE(PG8_SB(0, 1), b2 + hstep, voffB);
            PG8_WAIT_V(6); PG8_BAR; PG8_MMA(1, 1, At, B1); PG8_BAR;
            PG8_LDB(B0, 1, 0); PG8_SCHED; PG8_LDA(At, 1, 0); PG8_STAGE(PG8_SA(0, 1), a2 + hstep, voffA);
            PG8_WAIT_L(8); PG8_BAR; PG8_WAIT_L(0); PG8_MMA(0, 0, At, B0); PG8_BAR; PG8_SCHED;
            PG8_LDB(B1, 1, 1); PG8_STAGE(PG8_SB(1, 0), b3, voffB);
            PG8_BAR; PG8_WAIT_L(0); PG8_MMA(0, 1, At, B1); PG8_BAR;
            PG8_LDA(At, 1, 1); PG8_STAGE(PG8_SA(1, 0), a3, voffA);
            PG8_BAR; PG8_WAIT_L(0); PG8_MMA(1, 0, At, B0); PG8_BAR; PG8_SCHED;
            PG8_STAGE(PG8_SB(1, 1), b3 + hstep, voffB);
            PG8_WAIT_V(6); PG8_BAR; PG8_MMA(1, 1, At, B1); PG8_BAR;
            }
        }
        if constexpr (ALIGN_EPI) { if (wr == 0) PG8_BAR; }
        if constexpr (!Epi::AFTER_DRAIN) { E(acc, cur, wr, wc, fr, fq); S.done(cur); }
        if (!has_next) break;
#pragma unroll
        for (int a = 0; a < 2; ++a)
#pragma unroll
            for (int b = 0; b < 2; ++b)
#pragma unroll
                for (int m = 0; m < 4; ++m)
#pragma unroll
                    for (int n = 0; n < 2; ++n) acc[a][b][m][n] = (f32x4){0.f, 0.f, 0.f, 0.f};
        cur = nxt; cA = nA; cB = nB; ++ui;
        if constexpr (ALIGN_EPI) { if (wr == 1) PG8_BAR; }
    }
    PG8_WAIT_V(0);
    if constexpr (!ALIGN_EPI) { if (wr == 0) PG8_BAR; }
    PG8_BAR;
    if constexpr (Epi::AFTER_DRAIN) { E.fused(acc, cur, wr, wc, fr, fq, lds, wid, lane); S.done(cur); }
#undef PG8_SA
#undef PG8_SB
#undef PG8_STAGE
#undef PG8_LDA
#undef PG8_LDB
#undef PG8_MMA
#undef PG8_WAIT_V
#undef PG8_WAIT_L
#undef PG8_BAR
#undef PG8_SCHED
}
}
#ifndef PH_GEMM
#define PH_GEMM 1
#endif

#define GAS __attribute__((address_space(1)))
#define LAS __attribute__((address_space(3)))
typedef unsigned short bf16;
typedef unsigned v4u __attribute__((ext_vector_type(4)));
typedef unsigned v2u __attribute__((ext_vector_type(2)));
typedef float f32x4 __attribute__((ext_vector_type(4)));
typedef float f32x2 __attribute__((ext_vector_type(2)));
typedef float f32x16 __attribute__((ext_vector_type(16)));
typedef short bf16x8 __attribute__((ext_vector_type(8)));
typedef short s16x4 __attribute__((ext_vector_type(4)));
#ifndef SCAN_SMEM
#define SCAN_SMEM 1
#endif
#if SCAN_SMEM
typedef __attribute__((address_space(4))) const float cfloat;
#else
typedef const float cfloat;
#endif
using pg8::Unit;
extern __shared__ __attribute__((aligned(16))) unsigned char g_lds[];
constexpr int PTAB_OFF = 131072;
__device__ __forceinline__ const float* ptr(int i) { const unsigned long long v = *(const volatile unsigned long long*)(g_lds + PTAB_OFF + 8 * i);
    const unsigned lo = __builtin_amdgcn_readfirstlane((unsigned)v), hi = __builtin_amdgcn_readfirstlane((unsigned)(v >> 32)); return (const float*)(GAS const float*)(((unsigned long long)hi << 32) | lo); }
#define P_H ((float*)ptr(33))
#define P_WS ((unsigned char*)ptr(34))

constexpr int T = 16384, SEQ = 8192, D = 1024, FFN = 2816;
constexpr int NCH = 64, CHL = SEQ / NCH;
constexpr float EPS = 1e-6f;
constexpr size_t MiB = 1u << 20;
constexpr size_t WS_RSS = 0, WS_ROPE = 2 * MiB, WS_HA = 4 * MiB, WS_W = 36 * MiB, WS_PB = 68 * MiB, WS_R = 76 * MiB, WS_NEED = 352 * MiB;
constexpr size_t W_HYBIN = 0, W_LORA = 7 * MiB, W_HYBOUT = 8 * MiB + 512 * 1024;
constexpr size_t W_DOWN = 0, W_UQ = 2 * MiB, W_UKV = 4 * MiB, W_WO = 6 * MiB;
constexpr size_t W_FFNIN = 12 * MiB, W_FFNOUT = 23 * MiB, W_PLEP = 28 * MiB + 512 * 1024, W_PLEG = 29 * MiB;
constexpr size_t R_QK = 0, R_VTSB = 32 * MiB, R_G = 80 * MiB  , R_RWP = 48 * MiB, R_PL = 48 * MiB, R_SCAN = 106 * MiB;
constexpr size_t R_GATE = 0, R_ACT = 88 * MiB, R_PE = 176 * MiB;
constexpr size_t R_CQ = 0, R_CKV = 12 * MiB, R_KROPE = 20 * MiB, R_Q = 24 * MiB, R_KN = 72 * MiB, R_VT = 104 * MiB, R_O = 136 * MiB;
constexpr size_t HA_VBF = 0, HA_ACAT = 16 * MiB;
constexpr size_t R_HA2 = 208 * MiB;
constexpr int RWP_LD = 1856;
constexpr size_t R_RSP = 266 * MiB; constexpr size_t RSP_BYTES = 2 * MiB;
enum { RB_ATTN = 0, RB_FFN = 1, RB_GATE = 2, RB_PE = 3, RB_MLA = 4 };

__device__ __forceinline__ unsigned f2bf(float f) { unsigned u = __builtin_bit_cast(unsigned, f); return (u + 0x7fffu + ((u >> 16) & 1u)) >> 16; }
__device__ __forceinline__ unsigned pk2(float lo, float hi) { return pg8::cvt_pk_bf16(lo, hi); }
__device__ __forceinline__ float bflo(unsigned u) { return __builtin_bit_cast(float, u << 16); }
__device__ __forceinline__ float bfhi(unsigned u) { return __builtin_bit_cast(float, u & 0xffff0000u); }
__device__ __forceinline__ v2u pk4(f32x4 v) { v2u o; o.x = pk2(v[0], v[1]); o.y = pk2(v[2], v[3]); return o; }
__device__ __forceinline__ f32x4 unpk4(v2u u) { return (f32x4){bflo(u.x), bfhi(u.x), bflo(u.y), bfhi(u.y)}; }
__device__ __forceinline__ float sigmoidf_(float x) { return 1.0f / (1.0f + __expf(-x)); }
__device__ __forceinline__ float softplusf_(float x) { return fmaxf(x, 0.f) + __logf(1.0f + __expf(-fabsf(x))); }
__device__ __forceinline__ float tanhf_(float x) { const float e = __expf(-2.0f * fabsf(x)); const float r = (1.0f - e) / (1.0f + e); return x < 0.f ? -r : r; }
__device__ __forceinline__ float rstd_of(const float* rsp, int row, float invn, int nslot4 = 4) { const f32x4* p = (const f32x4*)(rsp + (size_t)row * 32); float s = 0.f;
    for (int i = 0; i < nslot4; ++i) { const f32x4 v = p[i]; s += (v[0] + v[1]) + (v[2] + v[3]); } return rsqrtf(s * invn + EPS); }
__device__ __forceinline__ int crow(int r, int hi) { return (r & 3) + 8 * (r >> 2) + 4 * hi; }

#define EPI_HEAD const int rowb = u.pm * 256 + wr * 64 + fr; const int colb = u.pn * 256 + wc * 32 + 4 * fq; (void)rowb; (void)colb;
#define EPI_ROWS _Pragma("unroll") for (int ai = 0; ai < 2; ++ai) _Pragma("unroll") for (int m = 0; m < 4; ++m) for (int once_ = (__builtin_amdgcn_sched_barrier(0), 0); once_ < 1; ++once_, ({ asm volatile("" ::: "memory"); }))
#define EPI_ROWS_NF _Pragma("unroll") for (int ai = 0; ai < 2; ++ai) _Pragma("unroll") for (int m = 0; m < 4; ++m)
#define EPI_COLS _Pragma("unroll") for (int bj = 0; bj < 2; ++bj) _Pragma("unroll") for (int n = 0; n < 2; ++n)
typedef const f32x4 (&AccRef)[2][2][4][2];

struct EpiHybIn { static constexpr bool PERM = false, AFTER_DRAIN = false;
    int layer;
    __device__ __forceinline__ void operator()(AccRef acc, const Unit& u, int wr, int wc, int fr, int fq) const { EPI_HEAD unsigned char* wsb = P_WS; const float* rss = (float*)(wsb + WS_R + R_RSP + RB_ATTN * RSP_BYTES); bf16* qk = (bf16*)(wsb + WS_R + R_QK); bf16* vt = (bf16*)(wsb + WS_R + R_VTSB); bf16* rwp = (bf16*)(wsb + WS_R + R_RWP);
        EPI_ROWS_NF { const int row = rowb + ai * 128 + m * 16; const float rs = rstd_of(rss, row, 1.f / 1024.f);
            EPI_COLS { const int col = colb + bj * 128 + n * 16; const f32x4 v = acc[ai][bj][m][n] * rs;
                if (col < 1024) { const f32x4 w = col < 512 ? v * 0.125f : v; *(v2u*)(qk + (size_t)row * 1024 + col) = pk4(w); }
                else if (col < 1536) { const int c = col - 1024, hh = c >> 6, d = c & 63, b = row >> 13, t = row & 8191; bf16* p = vt + ((size_t)((b * 8 + hh) * 64 + d)) * SEQ + t;
                    p[0] = (bf16)f2bf(v[0]); p[SEQ] = (bf16)f2bf(v[1]); p[2 * SEQ] = (bf16)f2bf(v[2]); p[3 * SEQ] = (bf16)f2bf(v[3]); }
                else if (col < 3360) { *(v2u*)(rwp + (size_t)row * RWP_LD + (col - 1536)) = pk4(v); } } }
    } };

struct EpiLora { static constexpr bool PERM = false, AFTER_DRAIN = false;
    int layer;
    __device__ __forceinline__ void operator()(AccRef acc, const Unit& u, int wr, int wc, int fr, int fq) const { EPI_HEAD unsigned char* wsb = P_WS; const int jl = layer >> 1; float* scanop = (float*)(wsb + WS_R + R_SCAN); bf16* g = (bf16*)(wsb + WS_R + R_G); const float* w0 = ptr(16) + (size_t)jl * 512; const float* a0 = ptr(18) + (size_t)jl * 512; const float* k_a = ptr(22) + (size_t)jl * 512;
        EPI_ROWS_NF { const int row = rowb + ai * 128 + m * 16; const int b = row >> 13, t = row & 8191;
            EPI_COLS { const int col = colb + bj * 128 + n * 16; const f32x4 v = acc[ai][bj][m][n];
                if (col < 512) { const int c = col; float* base = scanop + ((size_t)(b * 8 + (c >> 6)) * SEQ + t) * 320 + (c & 63); const f32x4 w0v = *(const f32x4*)(w0 + c); f32x4 o;
                    _Pragma("unroll") for (int j = 0; j < 4; ++j) { const float wv = -softplusf_(-(w0v[j] + v[j])) - 0.5f; o[j] = __expf(-__expf(wv)); }
                    *(f32x4*)(base + 64) = o; }
                else if (col < 1024) { const int c = col - 512; float* base = scanop + ((size_t)(b * 8 + (c >> 6)) * SEQ + t) * 320 + (c & 63); const f32x4 a0v = *(const f32x4*)(a0 + c), kav = *(const f32x4*)(k_a + c);
                    const f32x4 kk = *(const f32x4*)(base), k = *(const f32x4*)(base + 192); f32x4 oka, ok;
                    _Pragma("unroll") for (int j = 0; j < 4; ++j) { const float a = sigmoidf_(a0v[j] + v[j]); oka[j] = kk[j] * a; ok[j] = k[j] * (1.0f + (a - 1.0f) * kav[j]); }
                    *(f32x4*)(base + 128) = oka; *(f32x4*)(base + 192) = ok; }
                else { *(v2u*)(g + (size_t)row * 512 + (col - 1024)) = pk4(v); } } }
    } };

struct EpiResid { static constexpr bool PERM = false, AFTER_DRAIN = false;
    int layer; int mode;
    __device__ __forceinline__ void operator()(AccRef acc, const Unit& u, int wr, int wc, int fr, int fq) const { EPI_HEAD unsigned char* wsb = P_WS; float* h = P_H; bf16* hA = (bf16*)(wsb + WS_HA); const float* gnext = ptr(mode == 0 ? 4 : 11) + (size_t)layer * 1024; float* rss_next = (float*)(wsb + WS_R + R_RSP + (mode == 0 ? RB_FFN : RB_GATE) * RSP_BYTES);
        EPI_ROWS_NF { const int row = rowb + ai * 128 + m * 16; float ss = 0.f;
            EPI_COLS { const int col = colb + bj * 128 + n * 16; float* hp = h + (size_t)row * 1024 + col; const f32x4 hv = *(const f32x4*)hp + acc[ai][bj][m][n]; *(f32x4*)hp = hv;
                ss += (hv[0] * hv[0] + hv[1] * hv[1]) + (hv[2] * hv[2] + hv[3] * hv[3]);
                if (hA) { const f32x4 gv = *(const f32x4*)(gnext + col); *(v2u*)(hA + (size_t)row * 1024 + col) = pk4(hv * gv); } }
            ss += __shfl_xor(ss, 16); ss += __shfl_xor(ss, 32); if (fq == 0) rss_next[(size_t)row * 32 + u.pn * 4 + wc] = ss; }
    } };

struct EpiPleGate { static constexpr bool PERM = false, AFTER_DRAIN = false;
    int layer;
    __device__ __forceinline__ void operator()(AccRef acc, const Unit& u, int wr, int wc, int fr, int fq) const { EPI_HEAD unsigned char* wsb = P_WS; float* h = P_H; bf16* hA = layer < 3 ? (bf16*)(wsb + WS_R + R_HA2) : (bf16*)nullptr; const float* gnext = ptr(3) + (size_t)(layer < 3 ? layer + 1 : 0) * 1024; float* rss_next = (float*)(wsb + WS_R + R_RSP + RB_ATTN * RSP_BYTES); const float* rss_gate = (float*)(wsb + WS_R + R_RSP + RB_GATE * RSP_BYTES); const float* rss_pe = (float*)(wsb + WS_R + R_RSP + RB_PE * RSP_BYTES); const bf16* pe = (const bf16*)(wsb + WS_R + R_PE); const float* ple_norm = ptr(10) + (size_t)layer * 1024;
        EPI_ROWS_NF { const int row = rowb + ai * 128 + m * 16; float ss = 0.f; const float rg = rstd_of(rss_gate, row, 1.f / 1024.f), rp = rstd_of(rss_pe, row, 1.f / 1024.f);
            EPI_COLS { const int col = colb + bj * 128 + n * 16; float* hp = h + (size_t)row * 1024 + col; const f32x4 a = acc[ai][bj][m][n] * rg;
                const f32x4 e = unpk4(*(const v2u*)(pe + (size_t)row * 1024 + col)) * rp * *(const f32x4*)(ple_norm + col); f32x4 hv = *(const f32x4*)hp;
                _Pragma("unroll") for (int j = 0; j < 4; ++j) hv[j] += sigmoidf_(a[j]) * e[j];
                *(f32x4*)hp = hv; ss += (hv[0] * hv[0] + hv[1] * hv[1]) + (hv[2] * hv[2] + hv[3] * hv[3]);
                if (hA) { const f32x4 gv = *(const f32x4*)(gnext + col); *(v2u*)(hA + (size_t)row * 1024 + col) = pk4(hv * gv); } }
            ss += __shfl_xor(ss, 16); ss += __shfl_xor(ss, 32); if (fq == 0) rss_next[(size_t)row * 32 + u.pn * 4 + wc] = ss; }
    } };

struct EpiFfnG { static constexpr bool PERM = false, AFTER_DRAIN = false;
    int layer;
    __device__ __forceinline__ void operator()(AccRef acc, const Unit& u, int wr, int wc, int fr, int fq) const { EPI_HEAD unsigned char* wsb = P_WS; const float* rss = (float*)(wsb + WS_R + R_RSP + RB_FFN * RSP_BYTES); bf16* gate_in = (bf16*)(wsb + WS_R + R_GATE);
        EPI_ROWS_NF { const int row = rowb + ai * 128 + m * 16; const float rs = rstd_of(rss, row, 1.f / 1024.f); if (u.pn == 0 && wc == 0 && fq == 0) ((float*)rss)[(size_t)row * 32 + 16] = rs;
            EPI_COLS { const int col = colb + bj * 128 + n * 16; *(v2u*)(gate_in + (size_t)row * FFN + col) = pk4(acc[ai][bj][m][n] * rs); } }
    } };

struct EpiFfnU { static constexpr bool PERM = false, AFTER_DRAIN = false;
    int layer;
    __device__ __forceinline__ void operator()(AccRef acc, const Unit& u, int wr, int wc, int fr, int fq) const { unsigned char* wsb = P_WS; const float* rss = (float*)(wsb + WS_R + R_RSP + RB_FFN * RSP_BYTES); const bf16* gate_in = (const bf16*)(wsb + WS_R + R_GATE); bf16* act = (bf16*)(wsb + WS_R + R_ACT); const float* cw = ptr(6) + (size_t)layer * 3 * FFN; const float* cb = ptr(7) + (size_t)layer * FFN;
        const int rowb = u.pm * 256 + wr * 64 + fr, colb = u.pn * 256 + wc * 32 + 4 * fq;
        _Pragma("unroll") for (int bj = 0; bj < 2; ++bj) _Pragma("unroll") for (int n = 0; n < 2; ++n) { const int col = colb + bj * 128 + 16 * n;
            const f32x4 c0 = *(const f32x4*)(cw + col), c1 = *(const f32x4*)(cw + FFN + col), c2 = *(const f32x4*)(cw + 2 * FFN + col), cbv = *(const f32x4*)(cb + col);
            _Pragma("unroll") for (int r = 0; r < 8; ++r) { const int row = rowb + (r >> 2) * 128 + (r & 3) * 16; const int t = row & 8191; const bf16* gp = gate_in + (size_t)row * FFN + col;
                const v2u q0 = *(const v2u*)gp, q1 = *(const v2u*)(gp - (t >= 1 ? FFN : 0)), q2 = *(const v2u*)(gp - (t >= 2 ? 2 * FFN : 0));
                const f32x4 uu = acc[r >> 2][bj][r & 3][n] * rss[(size_t)row * 32 + 16]; const f32x4 g0 = unpk4(q0); f32x4 g1 = unpk4(q1), g2 = unpk4(q2);
                if (t < 1) g1 = (f32x4){0.f, 0.f, 0.f, 0.f}; if (t < 2) g2 = (f32x4){0.f, 0.f, 0.f, 0.f};
                const f32x4 cc = c0 * g2 + c1 * g1 + c2 * g0 + cbv;
                const pg8::f32x2 ga = pg8::gelu_pk((pg8::f32x2){cc[0], cc[1]}), gb = pg8::gelu_pk((pg8::f32x2){cc[2], cc[3]});
                *(v2u*)(act + (size_t)row * FFN + col) = (v2u){pk2(ga.x * uu[0], ga.y * uu[1]), pk2(gb.x * uu[2], gb.y * uu[3])}; if ((r & 3) == 3) asm volatile("" ::: "memory"); } }
    } };

struct EpiPe { static constexpr bool PERM = false, AFTER_DRAIN = false;
    int layer;
    __device__ __forceinline__ void operator()(AccRef acc, const Unit& u, int wr, int wc, int fr, int fq) const { EPI_HEAD unsigned char* wsb = P_WS; bf16* pe = (bf16*)(wsb + WS_R + R_PE); float* rss_pe = (float*)(wsb + WS_R + R_RSP + RB_PE * RSP_BYTES);
        EPI_ROWS_NF { const int row = rowb + ai * 128 + m * 16; float ss = 0.f;
            EPI_COLS { const int col = colb + bj * 128 + n * 16; const f32x4 v = acc[ai][bj][m][n]; ss += (v[0] * v[0] + v[1] * v[1]) + (v[2] * v[2] + v[3] * v[3]); *(v2u*)(pe + (size_t)row * 1024 + col) = pk4(v); }
            ss += __shfl_xor(ss, 16); ss += __shfl_xor(ss, 32); if (fq == 0) rss_pe[(size_t)row * 32 + u.pn * 4 + wc] = ss; }
    } };

__device__ __forceinline__ void rope4(const float* tab, int row, int fq, f32x4 x1, f32x4 x2, f32x4& o1, f32x4& o2) {
    const f32x4 cs = *(const f32x4*)(tab + (size_t)row * 32 + 4 * fq), sn = *(const f32x4*)(tab + (size_t)row * 32 + 16 + 4 * fq);
    o1 = x1 * cs - x2 * sn; o2 = x1 * sn + x2 * cs;
}

struct EpiMlaDown { static constexpr bool PERM = false, AFTER_DRAIN = false;
    int layer;
    __device__ __forceinline__ void operator()(AccRef acc, const Unit& u, int wr, int wc, int fr, int fq) const { EPI_HEAD unsigned char* wsb = P_WS; const int jl = layer >> 1; const float* rss = (float*)(wsb + WS_R + R_RSP + RB_ATTN * RSP_BYTES); bf16* cq = (bf16*)(wsb + WS_R + R_CQ); bf16* ckv = (bf16*)(wsb + WS_R + R_CKV); bf16* krope = (bf16*)(wsb + WS_R + R_KROPE); const float* q_norm = ptr(27) + (size_t)jl * 384; const float* kv_norm = ptr(28) + (size_t)jl * 256; float* rss_mla = (float*)(wsb + WS_R + R_RSP + RB_MLA * RSP_BYTES); (void)jl; const float* tab = (const float*)(wsb + WS_ROPE);
        EPI_ROWS_NF { const int row = rowb + ai * 128 + m * 16; const float rs = rstd_of(rss, row, 1.f / 1024.f);
            _Pragma("unroll") for (int bj = 0; bj < 2; ++bj) { const int cb0 = u.pn * 256 + bj * 128;
                if (cb0 < 640) { float ss = 0.f;
                    _Pragma("unroll") for (int n = 0; n < 2; ++n) { const int col = colb + bj * 128 + n * 16; const f32x4 v = acc[ai][bj][m][n] * rs; ss += (v[0] * v[0] + v[1] * v[1]) + (v[2] * v[2] + v[3] * v[3]);
                        if (cb0 < 384) *(v2u*)(cq + (size_t)row * 384 + col) = pk4(v * *(const f32x4*)(q_norm + col));
                        else *(v2u*)(ckv + (size_t)row * 256 + (col - 384)) = pk4(v * *(const f32x4*)(kv_norm + col - 384)); }
                    ss += __shfl_xor(ss, 16); ss += __shfl_xor(ss, 32); if (fq == 0) rss_mla[(size_t)row * 32 + (u.pn * 2 + bj) * 4 + wc] = ss; }
                else if (cb0 == 640 && wc == 0) { f32x4 o1, o2; rope4(tab, row, fq, acc[ai][bj][m][0] * rs, acc[ai][bj][m][1] * rs, o1, o2);
                    *(v2u*)(krope + (size_t)row * 32 + 4 * fq) = pk4(o1); *(v2u*)(krope + (size_t)row * 32 + 16 + 4 * fq) = pk4(o2); } } }
    } };

constexpr float QSCALE = 0.10206207261596575f * 1.4426950408889634f;
struct EpiUq { static constexpr bool PERM = false, AFTER_DRAIN = false;
    int layer;
    __device__ __forceinline__ void operator()(AccRef acc, const Unit& u, int wr, int wc, int fr, int fq) const { EPI_HEAD unsigned char* wsb = P_WS; const float* rss_cq = (float*)(wsb + WS_R + R_RSP + RB_MLA * RSP_BYTES); bf16* q = (bf16*)(wsb + WS_R + R_Q); const float* tab = (const float*)(wsb + WS_ROPE);
        EPI_ROWS_NF { const int row = rowb + ai * 128 + m * 16; const float rs = rstd_of(rss_cq, row, 1.f / 384.f, 3) * QSCALE;
            _Pragma("unroll") for (int bj = 0; bj < 2; ++bj) { const int c0 = u.pn * 256 + bj * 128 + wc * 32; bf16* qp = q + (size_t)row * 1536 + c0 + 4 * fq;
                f32x4 v0 = acc[ai][bj][m][0] * rs, v1 = acc[ai][bj][m][1] * rs;
                if (((c0 >> 5) % 3) == 2) { f32x4 o1, o2; rope4(tab, row, fq, v0, v1, o1, o2); v0 = o1; v1 = o2; }
                *(v2u*)qp = pk4(v0); *(v2u*)(qp + 16) = pk4(v1); } }
    } };

struct EpiUkv { static constexpr bool PERM = false, AFTER_DRAIN = false;
    int layer;
    __device__ __forceinline__ void operator()(AccRef acc, const Unit& u, int wr, int wc, int fr, int fq) const { EPI_HEAD unsigned char* wsb = P_WS; const float* rss_ckv = (float*)(wsb + WS_R + R_RSP + RB_MLA * RSP_BYTES) + 12; bf16* kn = (bf16*)(wsb + WS_R + R_KN); bf16* vt = (bf16*)(wsb + WS_R + R_VT);
        EPI_ROWS_NF { const int row = rowb + ai * 128 + m * 16; const float rs = rstd_of(rss_ckv, row, 1.f / 256.f, 2); const int b = row >> 13, t = row & 8191;
            EPI_COLS { const int col = colb + bj * 128 + n * 16; const int hh = col >> 7, wi = col & 127; const f32x4 v = acc[ai][bj][m][n] * rs;
                if (wi < 64) *(v2u*)(kn + (size_t)row * 1024 + hh * 64 + wi) = pk4(v);
                else { bf16* p = vt + ((size_t)((b * 16 + hh) * 64 + (wi - 64))) * SEQ + t; p[0] = (bf16)f2bf(v[0]); p[SEQ] = (bf16)f2bf(v[1]); p[2 * SEQ] = (bf16)f2bf(v[2]); p[3 * SEQ] = (bf16)f2bf(v[3]); } } }
    } };

#ifndef GEMM_MASK
#define GEMM_MASK 0xFFFF
#endif
template <int ID, class E> __device__ __forceinline__ void run_gemm(LAS unsigned char* lds, const bf16* A, const bf16* Bt, int M, int N, int K, const E& e) {
    asm volatile("" : "+s"(K)); asm volatile("" : "+s"(N));
    pg8::Gemm g{A, Bt, M, N, K}; pg8::StaticOrder S; S.init(M, N, (int)gridDim.x, (int)blockIdx.x);
#if PH_GEMM
    if constexpr ((GEMM_MASK >> ID) & 1) pg8::gemm_phase<E, pg8::StaticOrder, true, true>(lds, g, S, e);
#endif
}

struct Ctx { int tid, lane, wid, gw, NGW; unsigned char* lds; };
__device__ __forceinline__ Ctx mk_ctx() { Ctx c; int t = threadIdx.x; asm volatile("" : "+v"(t)); int b = blockIdx.x; asm volatile("" : "+s"(b));
    c.tid = t; c.lane = t & 63; c.wid = __builtin_amdgcn_readfirstlane(t >> 6); c.gw = b * 8 + c.wid; c.NGW = gridDim.x * 8; c.lds = g_lds; return c; }
#define LDS_WAIT() asm volatile("s_waitcnt lgkmcnt(0)" ::: "memory")

__device__ __forceinline__ void transpose_mat(const Ctx& c, const float* W, int K, int N, bf16* WT) {
    float* scr = (float*)(c.lds + c.wid * 16384); const int items = (K / 64) * (N / 32), nblk = N / 32, lane = c.lane;
    float tv[32];
    int it = c.gw;
    if (it < items) { const int k0 = 64 * (it / nblk), n0 = 32 * (it % nblk);
#pragma unroll
        for (int i = 0; i < 32; ++i) tv[i] = W[(size_t)(k0 + 2 * i + (lane >> 5)) * N + n0 + (lane & 31)]; }
    for (; it < items; it += c.NGW) { const int k0 = 64 * (it / nblk), n0 = 32 * (it % nblk);
#pragma unroll
        for (int i = 0; i < 32; ++i) scr[(2 * i + (lane >> 5)) * 33 + (lane & 31)] = tv[i];
        const int nx = it + c.NGW;
        if (nx < items) { const int k1 = 64 * (nx / nblk), n1 = 32 * (nx % nblk);
#pragma unroll
            for (int i = 0; i < 32; ++i) tv[i] = W[(size_t)(k1 + 2 * i + (lane >> 5)) * N + n1 + (lane & 31)]; }
        LDS_WAIT(); asm volatile("" ::: "memory");
        const int cc = lane & 7;
#pragma unroll
        for (int j = 0; j < 4; ++j) { const int n = (lane >> 3) + 8 * j; const float* s = scr + (8 * cc) * 33 + n;
            v4u o; o.x = pk2(s[0 * 33], s[1 * 33]); o.y = pk2(s[2 * 33], s[3 * 33]); o.z = pk2(s[4 * 33], s[5 * 33]); o.w = pk2(s[6 * 33], s[7 * 33]);
            *(v4u*)(WT + (size_t)(n0 + n) * K + k0 + 8 * cc) = o; }
        LDS_WAIT(); asm volatile("" ::: "memory");
    }
}
__device__ __forceinline__ void zero_bytes16(const Ctx& c, void* p, size_t bytes) {
    v4u* q = (v4u*)p; const size_t n = bytes / 16; const v4u z = {0u, 0u, 0u, 0u};
    for (size_t i = (size_t)c.gw * 64 + c.lane; i < n; i += (size_t)c.NGW * 64) q[i] = z;
}
struct In { __device__ __forceinline__ const float* operator[](int i) const { return ptr(i); } };
__device__ __forceinline__ void conv_mixer(const Ctx&, const In& in, unsigned char* ws, int layer) { const Ctx c = mk_ctx();
    const int j = layer >> 1; unsigned char* W = ws + WS_W;
    if ((layer & 1) == 0) {
        transpose_mat(c, in[13] + (size_t)j * 1024 * 3360, 1024, 3360, (bf16*)(W + W_HYBIN));
        zero_bytes16(c, W + W_HYBIN + (size_t)3360 * 1024 * 2, (size_t)224 * 1024 * 2);
        transpose_mat(c, in[14] + (size_t)j * 1024 * 1024, 1024, 1024, (bf16*)(W + W_HYBOUT));
        bf16* L = (bf16*)(W + W_LORA); const float* w2 = in[17] + (size_t)j * 64 * 512; const float* a2 = in[19] + (size_t)j * 64 * 512; const float* g2 = in[20] + (size_t)j * 160 * 512;
        for (int i = c.gw * 64 + c.lane; i < 1536 * 384; i += c.NGW * 64) { const int n = i / 384, k = i % 384; float v = 0.f;
            if (n < 512) { if (k < 64) v = w2[k * 512 + n]; } else if (n < 1024) { if (k >= 64 && k < 128) v = a2[(k - 64) * 512 + n - 512]; } else { if (k >= 128 && k < 288) v = g2[(k - 128) * 512 + n - 1024]; }
            L[i] = (bf16)f2bf(v); }
    } else {
        transpose_mat(c, in[26] + (size_t)j * 1024 * 672, 1024, 672, (bf16*)(W + W_DOWN));
        zero_bytes16(c, W + W_DOWN + (size_t)672 * 1024 * 2, (size_t)96 * 1024 * 2);
        transpose_mat(c, in[29] + (size_t)j * 384 * 1536, 384, 1536, (bf16*)(W + W_UQ));
        transpose_mat(c, in[30] + (size_t)j * 256 * 2048, 256, 2048, (bf16*)(W + W_UKV));
        transpose_mat(c, in[31] + (size_t)j * 1024 * 1024, 1024, 1024, (bf16*)(W + W_WO));
    }
}
__device__ __forceinline__ void conv_ffn(const Ctx&, const In& in, unsigned char* ws, int layer) { const Ctx c = mk_ctx();
    unsigned char* W = ws + WS_W;
    transpose_mat(c, in[5] + (size_t)layer * 1024 * 5632, 1024, 5632, (bf16*)(W + W_FFNIN));
    transpose_mat(c, in[8] + (size_t)layer * 2816 * 1024, 2816, 1024, (bf16*)(W + W_FFNOUT));
    transpose_mat(c, in[9] + (size_t)layer * 256 * 1024, 256, 1024, (bf16*)(W + W_PLEP));
    transpose_mat(c, in[12] + (size_t)layer * 1024 * 1024, 1024, 1024, (bf16*)(W + W_PLEG));
}
__device__ __forceinline__ void conv_p(const Ctx&, const In& in, unsigned char* ws, int layer) { const Ctx c = mk_ctx();
    const f32x4* src = (const f32x4*)(in[1] + (size_t)layer * T * 256); v2u* dst = (v2u*)(ws + WS_PB);
    for (int i = c.gw * 64 + c.lane; i < T * 256 / 4; i += c.NGW * 64) dst[i] = pk4(src[i]);
}
__device__ __forceinline__ float wave_sum(float v) {
#pragma unroll
    for (int o = 1; o < 64; o <<= 1) v += __shfl_xor(v, o);
    return v;
}
__device__ __forceinline__ void phase0(const Ctx&, const In& in, float* h, unsigned char* ws) { const Ctx c = mk_ctx();
    float* rss = (float*)(ws + WS_R + R_RSP + RB_ATTN * RSP_BYTES);
    float* tab = (float*)(ws + WS_ROPE); const int* pos = (const int*)in[2];
    for (int i = c.gw * 64 + c.lane; i < T * 16; i += c.NGW * 64) { const int row = i >> 4, k = i & 15;
        const float inv = exp2f(-(float)k * (13.287712379549449f / 16.0f)); const float ang = (float)pos[row] * inv;
        const float kq = rintf(ang * 0.15915494309189535f); float r = fmaf(-kq, 6.28125f, ang); r = fmaf(-kq, 0.0019353071795864769f, r);
        tab[row * 32 + k] = cosf(r); tab[row * 32 + 16 + k] = sinf(r); }
    const float* x = in[0]; const float* g0 = in[3]; bf16* hA = (bf16*)(ws + WS_R + R_HA2);
    for (int row = c.gw; row < T; row += c.NGW) { float s = 0.f;
#pragma unroll
        for (int j = 0; j < 4; ++j) { const int col = 4 * c.lane + 256 * j; const f32x4 v = *(const f32x4*)(x + (size_t)row * 1024 + col); *(f32x4*)(h + (size_t)row * 1024 + col) = v;
            s += (v[0] * v[0] + v[1] * v[1]) + (v[2] * v[2] + v[3] * v[3]); *(v2u*)(hA + (size_t)row * 1024 + col) = pk4(v * *(const f32x4*)(g0 + col)); }
        s = wave_sum(s); if (c.lane < 16) rss[(size_t)row * 32 + c.lane] = c.lane == 0 ? s : 0.f; }
}
__device__ __forceinline__ void phase_final(const Ctx&, const In& in, float* h, unsigned char* ws) { const Ctx c = mk_ctx();
    const float* rss = (const float*)(ws + WS_R + R_RSP + RB_ATTN * RSP_BYTES); const float* g = in[32];
    for (int row = c.gw; row < T; row += c.NGW) { const float rs = rstd_of(rss, row, 1.f / 1024.f);
#pragma unroll
        for (int j = 0; j < 4; ++j) { const int col = 4 * c.lane + 256 * j; float* hp = h + (size_t)row * 1024 + col; *(f32x4*)hp = *(const f32x4*)hp * rs * *(const f32x4*)(g + col); } }
}

#define MFMA32(a, b, c) __builtin_amdgcn_mfma_f32_32x32x16_bf16((a), (b), (c), 0, 0, 0)
__device__ __forceinline__ bf16x8 pack8(const f32x16& x, int s) {
    v4u p; p.x = pk2(x[8 * s], x[8 * s + 1]); p.y = pk2(x[8 * s + 2], x[8 * s + 3]); p.z = pk2(x[8 * s + 4], x[8 * s + 5]); p.w = pk2(x[8 * s + 6], x[8 * s + 7]);
    return __builtin_bit_cast(bf16x8, p);
}
__device__ __forceinline__ bf16x8 cat4(v2u lo, v2u hi) { v4u p; p.x = lo.x; p.y = lo.y; p.z = hi.x; p.w = hi.y; return __builtin_bit_cast(bf16x8, p); }

__device__ __forceinline__ void sb_attn_phase(const Ctx&, bf16* qk, const bf16* vt) { const Ctx c = mk_ctx();
    const int r = c.lane & 31, hi = c.lane >> 5;
    for (int task = (int)blockIdx.x * 4 + (c.wid - 4); task < 16 * 256; task += (int)gridDim.x * 4) {
        const int chain = task >> 8, qblk = task & 255, b = chain >> 3, h = chain & 7, q0 = qblk * 32; const size_t rowbase = (size_t)b * SEQ;
        bf16x8 qr[4];
#pragma unroll
        for (int s = 0; s < 4; ++s) qr[s] = *(const bf16x8*)(qk + (rowbase + q0 + r) * 1024 + h * 64 + 16 * s + 8 * hi);
        f32x16 o[2]; o[0] = f32x16{}; o[1] = f32x16{}; float carry = 0.f;
        for (int jt = qblk; jt >= 0; --jt) { const int k0 = jt * 32;
            f32x16 z = f32x16{};
#pragma unroll
            for (int s = 0; s < 4; ++s) { const bf16x8 kf = *(const bf16x8*)(qk + (rowbase + k0 + r) * 1024 + 512 + h * 64 + 16 * s + 8 * hi); z = MFMA32(kf, qr[s], z); }
            const bool diag = (jt == qblk);
            f32x16 lom;
#pragma unroll
            for (int i = 0; i < 16; ++i) { const bool msk = diag && (crow(i, hi) >= r); lom[i] = msk ? 0.f : -softplusf_(z[i]); }
            float Tg[4], To[4]; f32x16 aft;
#pragma unroll
            for (int g = 0; g < 4; ++g) { aft[4 * g + 3] = 0.f; aft[4 * g + 2] = lom[4 * g + 3]; aft[4 * g + 1] = aft[4 * g + 2] + lom[4 * g + 2]; aft[4 * g] = aft[4 * g + 1] + lom[4 * g + 1]; Tg[g] = aft[4 * g] + lom[4 * g]; To[g] = __shfl_xor(Tg[g], 32); }
            float E = carry;
#pragma unroll
            for (int g = 3; g >= 0; --g) { const float off = E + (hi == 0 ? To[g] : 0.f);
#pragma unroll
                for (int e = 0; e < 4; ++e) { const int i = 4 * g + e; const bool msk = diag && (crow(i, hi) >= r); const float w = __expf(z[i] + lom[i] + aft[i] + off); z[i] = msk ? 0.f : w; }
                E += Tg[g] + To[g]; }
            carry = E;
            const bf16x8 pa0 = pack8(z, 0), pa1 = pack8(z, 1);
#pragma unroll
            for (int db = 0; db < 2; ++db) { const bf16* vp = vt + ((size_t)(chain * 64 + 32 * db + r)) * SEQ + k0 + 4 * hi;
                const bf16x8 v0 = cat4(*(const v2u*)(vp), *(const v2u*)(vp + 8)), v1 = cat4(*(const v2u*)(vp + 16), *(const v2u*)(vp + 24));
                o[db] = MFMA32(v0, pa0, o[db]); o[db] = MFMA32(v1, pa1, o[db]); }
            if (__all(carry < -40.0f)) break;
        }
        bf16* op = qk + (rowbase + q0 + r) * 1024 + h * 64;
#pragma unroll
        for (int db = 0; db < 2; ++db)
#pragma unroll
            for (int g = 0; g < 4; ++g) *(v2u*)(op + 32 * db + 8 * g + 4 * hi) = pk4((f32x4){o[db][4 * g], o[db][4 * g + 1], o[db][4 * g + 2], o[db][4 * g + 3]});
    }
}

__device__ __forceinline__ void rw_prep_phase(const Ctx&, const In& in, unsigned char* ws, int j) { const Ctx c = mk_ctx();
    const bf16* rwp = (const bf16*)(ws + WS_R + R_RWP); float* scanop = (float*)(ws + WS_R + R_SCAN); bf16* vbf = (bf16*)(ws + WS_HA + HA_VBF); bf16* acat = (bf16*)(ws + WS_HA + HA_ACAT);
    const float* mu = in[15] + (size_t)j * 1824; const float* k_k = in[21] + (size_t)j * 512;
    const int lane = c.lane, hh = lane >> 3, n0 = (lane & 7) * 8;
    for (int row = c.gw; row < T; row += c.NGW) { const int b = row >> 13, t = row & 8191; const bf16* cur = rwp + (size_t)row * RWP_LD; const bool hp = t > 0;
        float xm[3][8];
#pragma unroll
        for (int part = 0; part < 3; ++part) { const int ch = part * 512 + hh * 64 + n0; const v4u cu = *(const v4u*)(cur + ch); v4u pu = {0u, 0u, 0u, 0u}; if (hp) pu = *(const v4u*)(cur - RWP_LD + ch);
            const f32x4 m0 = *(const f32x4*)(mu + ch), m1 = *(const f32x4*)(mu + ch + 4);
#pragma unroll
            for (int q = 0; q < 4; ++q) { const float p0 = bflo(cu[q]), p1 = bfhi(cu[q]), a0 = bflo(pu[q]), a1 = bfhi(pu[q]); const float mm0 = q < 2 ? m0[2 * q] : m1[2 * q - 4], mm1 = q < 2 ? m0[2 * q + 1] : m1[2 * q - 3];
                xm[part][2 * q] = p0 + (a0 - p0) * mm0; xm[part][2 * q + 1] = p1 + (a1 - p1) * mm1; } }
        float* base = scanop + ((size_t)(b * 8 + hh) * SEQ + t) * 320 + n0;
        *(f32x4*)(base + 256) = (f32x4){xm[0][0], xm[0][1], xm[0][2], xm[0][3]}; *(f32x4*)(base + 260) = (f32x4){xm[0][4], xm[0][5], xm[0][6], xm[0][7]};
        *(f32x4*)(base + 192) = (f32x4){xm[1][0], xm[1][1], xm[1][2], xm[1][3]}; *(f32x4*)(base + 196) = (f32x4){xm[1][4], xm[1][5], xm[1][6], xm[1][7]};
        const f32x4 kk0 = *(const f32x4*)(k_k + hh * 64 + n0), kk1 = *(const f32x4*)(k_k + hh * 64 + n0 + 4); float kk[8]; float ss = 0.f;
#pragma unroll
        for (int q = 0; q < 8; ++q) { kk[q] = xm[1][q] * (q < 4 ? kk0[q] : kk1[q - 4]); ss += kk[q] * kk[q]; }
        ss += __shfl_xor(ss, 1); ss += __shfl_xor(ss, 2); ss += __shfl_xor(ss, 4);
        const float rn = rsqrtf(fmaxf(ss, 1e-24f));
        *(f32x4*)(base) = (f32x4){kk[0] * rn, kk[1] * rn, kk[2] * rn, kk[3] * rn}; *(f32x4*)(base + 4) = (f32x4){kk[4] * rn, kk[5] * rn, kk[6] * rn, kk[7] * rn};
        { v4u o; o.x = pk2(xm[2][0], xm[2][1]); o.y = pk2(xm[2][2], xm[2][3]); o.z = pk2(xm[2][4], xm[2][5]); o.w = pk2(xm[2][6], xm[2][7]); *(v4u*)(vbf + ((size_t)(b * 8 + hh) * SEQ + t) * 64 + n0) = o; }
        if (lane < 48) { v4u o = {0u, 0u, 0u, 0u};
            if (lane < 36) { const int ch = 1536 + 8 * lane; const v4u cu = *(const v4u*)(cur + ch); v4u pu = {0u, 0u, 0u, 0u}; if (hp) pu = *(const v4u*)(cur - RWP_LD + ch);
                const f32x4 m0 = *(const f32x4*)(mu + ch), m1 = *(const f32x4*)(mu + ch + 4); float y[8];
#pragma unroll
                for (int q = 0; q < 4; ++q) { const float p0 = bflo(cu[q]), p1 = bfhi(cu[q]), a0 = bflo(pu[q]), a1 = bfhi(pu[q]); const float mm0 = q < 2 ? m0[2 * q] : m1[2 * q - 4], mm1 = q < 2 ? m0[2 * q + 1] : m1[2 * q - 3];
                    y[2 * q] = p0 + (a0 - p0) * mm0; y[2 * q + 1] = p1 + (a1 - p1) * mm1; }
#pragma unroll
                for (int q = 0; q < 8; ++q) y[q] = lane < 8 ? tanhf_(y[q]) : (lane < 16 ? y[q] : sigmoidf_(y[q]));
                o.x = pk2(y[0], y[1]); o.y = pk2(y[2], y[3]); o.z = pk2(y[4], y[5]); o.w = pk2(y[6], y[7]); }
            *(v4u*)(acat + (size_t)row * 384 + 8 * lane) = o; }
    }
}

constexpr int SCAN_PF = 4;

typedef float f32x16s __attribute__((ext_vector_type(16)));
#define SL4(a, b, c, d, p, o0, o1, o2, o3) asm volatile("s_load_dwordx16 %0, %4, %5\n\ts_load_dwordx16 %1, %4, %6\n\ts_load_dwordx16 %2, %4, %7\n\ts_load_dwordx16 %3, %4, %8\n\ts_waitcnt lgkmcnt(0)" : "=&s"(a), "=&s"(b), "=&s"(c), "=&s"(d) : "s"(p), "i"(o0), "i"(o1), "i"(o2), "i"(o3) : "memory")
#define SL3(a, b, c, p, o0, o1, o2) asm volatile("s_load_dwordx16 %0, %3, %4\n\ts_load_dwordx16 %1, %3, %5\n\ts_load_dwordx16 %2, %3, %6\n\ts_waitcnt lgkmcnt(0)" : "=&s"(a), "=&s"(b), "=&s"(c) : "s"(p), "i"(o0), "i"(o1), "i"(o2) : "memory")
#define SL2(a, b, p, o0, o1) asm volatile("s_load_dwordx16 %0, %2, %3\n\ts_load_dwordx16 %1, %2, %4\n\ts_waitcnt lgkmcnt(0)" : "=&s"(a), "=&s"(b) : "s"(p), "i"(o0), "i"(o1) : "memory")
#define PR(v, p) ((f32x2){(v)[2 * (p)], (v)[2 * (p) + 1]})
#define SCAN_SA(S, o) ({ f32x16s k0_, k1_, k2_, k3_; SL4(k0_, k1_, k2_, k3_, o, 0, 64, 128, 192); f32x2 sa2_ = {0.f, 0.f}; \
    _Pragma("unroll") for (int p_ = 0; p_ < 8; ++p_) { sa2_ += S[p_] * PR(k0_, p_); sa2_ += S[8 + p_] * PR(k1_, p_); sa2_ += S[16 + p_] * PR(k2_, p_); sa2_ += S[24 + p_] * PR(k3_, p_); } -(sa2_.x + sa2_.y); })

__device__ __forceinline__ void scan_pass1(const Ctx&, unsigned char* ws, int rot) { const Ctx c = mk_ctx();
    const float* scanop = (const float*)(ws + WS_R + R_SCAN); const bf16* vbf = (const bf16*)(ws + WS_HA + HA_VBF); float* PL = (float*)(ws + WS_R + R_PL);
    const int lane = c.lane; float pfdummy = 0.f;
    if (c.wid >= 4) return;
    for (int task = (int)((blockIdx.x + (rot ? gridDim.x / 2 : 0)) % gridDim.x) * 4 + c.wid; task < 16 * (NCH - 1); task += gridDim.x * 4) {
        const int cc = task % (NCH - 1), chain = task / (NCH - 1);
        f32x2 SP[32], SLs[32];
#pragma unroll
        for (int j = 0; j < 32; ++j) { SP[j].x = (2 * j == lane) ? 1.f : 0.f; SP[j].y = (2 * j + 1 == lane) ? 1.f : 0.f; SLs[j] = (f32x2){0.f, 0.f}; }
        cfloat* ob = (cfloat*)(scanop + ((size_t)chain * SEQ + (size_t)cc * CHL) * 320);
        const float* og = scanop + ((size_t)chain * SEQ + (size_t)cc * CHL) * 320;
        const bf16* vp = vbf + ((size_t)chain * SEQ + (size_t)cc * CHL) * 64 + lane;
        f32x4 pfa = {0.f, 0.f, 0.f, 0.f}; float pfb = 0.f; unsigned short vnext = vp[0];
        for (int t = 0; t < CHL; ++t) { cfloat* o = ob + (size_t)t * 320;
            const unsigned short vcur = vnext; pfdummy += pfa[0] + pfb;
            vnext = vp[(size_t)(t + 1) * 64];
            pfa = *(const f32x4*)(og + (size_t)(t + SCAN_PF) * 320 + lane * 4); pfb = og[(size_t)(t + SCAN_PF) * 320 + 256 + lane];
            float saP, saL;
            { f32x16s k0_, k1_, k2_, k3_; SL4(k0_, k1_, k2_, k3_, o, 0, 64, 128, 192); f32x2 a2 = {0.f, 0.f}, b2 = {0.f, 0.f};
#pragma unroll
              for (int p_ = 0; p_ < 8; ++p_) { a2 += SP[p_] * PR(k0_, p_); b2 += SLs[p_] * PR(k0_, p_); a2 += SP[8 + p_] * PR(k1_, p_); b2 += SLs[8 + p_] * PR(k1_, p_);
                  a2 += SP[16 + p_] * PR(k2_, p_); b2 += SLs[16 + p_] * PR(k2_, p_); a2 += SP[24 + p_] * PR(k3_, p_); b2 += SLs[24 + p_] * PR(k3_, p_); }
              saP = -(a2.x + a2.y); saL = -(b2.x + b2.y); }
            const f32x2 savP = {saP, saP}, savL = {saL, saL}; const float v = __builtin_bit_cast(float, (unsigned)vcur << 16); const f32x2 vv = {v, v};
#define P1_BLK(b) { f32x16s w_, a_, k_; SL3(w_, a_, k_, o, 256 + 64 * (b), 512 + 64 * (b), 768 + 64 * (b)); _Pragma("unroll") for (int p_ = 0; p_ < 8; ++p_) { \
                f32x2 s = SP[8 * (b) + p_] * PR(w_, p_); s += savP * PR(a_, p_); SP[8 * (b) + p_] = s; \
                f32x2 l = SLs[8 * (b) + p_] * PR(w_, p_); l += savL * PR(a_, p_); l += vv * PR(k_, p_); SLs[8 * (b) + p_] = l; } }
            P1_BLK(0) P1_BLK(1) P1_BLK(2) P1_BLK(3)
#undef P1_BLK
        }
        float* dst = PL + (((size_t)chain * NCH + cc) * 2) * 4096 + lane * 64;
#pragma unroll
        for (int j = 0; j < 16; ++j) { *(f32x4*)(dst + 4 * j) = (f32x4){SP[2 * j].x, SP[2 * j].y, SP[2 * j + 1].x, SP[2 * j + 1].y}; *(f32x4*)(dst + 4096 + 4 * j) = (f32x4){SLs[2 * j].x, SLs[2 * j].y, SLs[2 * j + 1].x, SLs[2 * j + 1].y}; }
    }
    if (pfdummy == 1.2345e-30f) PL[0] = pfdummy;
}
__device__ __forceinline__ void scan_pass2(const Ctx&, unsigned char* ws) { const Ctx c = mk_ctx();
    float* PL = (float*)(ws + WS_R + R_PL); const int lane = c.lane;
    const int xcd_ = blockIdx.x & 7, tt_ = (blockIdx.x >> 3) * 8 + c.wid;
    for (int task = (gridDim.x == 256) ? ((tt_ < 128) ? ((xcd_ + 8 * (tt_ >> 6)) * 64 + (tt_ & 63)) : 16 * 64) : c.gw; task < 16 * 64; task += (gridDim.x == 256) ? 16 * 64 : c.NGW) { const int chain = task >> 6, i = task & 63;
        float s = 0.f;
        for (int cc = 0; cc < NCH - 1; ++cc) { float* P = PL + (((size_t)chain * NCH + cc) * 2) * 4096; float* L = P + 4096 + i * 64;
            float a0 = L[lane], a1 = 0.f, a2 = 0.f, a3 = 0.f;
#pragma unroll
            for (int k = 0; k < 64; k += 4) { a0 += __shfl(s, k) * P[k * 64 + lane]; a1 += __shfl(s, k + 1) * P[(k + 1) * 64 + lane]; a2 += __shfl(s, k + 2) * P[(k + 2) * 64 + lane]; a3 += __shfl(s, k + 3) * P[(k + 3) * 64 + lane]; }
            s = (a0 + a1) + (a2 + a3); L[lane] = s; }
    }
}
__device__ __forceinline__ void scan_pass3(const Ctx&, const In& in, unsigned char* ws, int jl, int rot) { const Ctx c = mk_ctx();
    const float* scanop = (const float*)(ws + WS_R + R_SCAN); const bf16* vbf = (const bf16*)(ws + WS_HA + HA_VBF); const float* PL = (const float*)(ws + WS_R + R_PL);
    const bf16* gbuf = (const bf16*)(ws + WS_R + R_G); bf16* oc = (bf16*)(ws + WS_R + R_QK);
    const float* r_k = in[23] + (size_t)jl * 512; const float* ln_w = in[24] + (size_t)jl * 512; const float* ln_b = in[25] + (size_t)jl * 512;
    const int lane = c.lane; float* yl = (float*)(c.lds + c.wid * 4096); float pfdummy = 0.f;
    if (c.wid >= 4) return;
    for (int task = (int)((blockIdx.x + (rot ? gridDim.x / 2 : 0)) % gridDim.x) * 4 + c.wid; task < 16 * NCH; task += gridDim.x * 4) { const int chain = task / NCH, cc = task % NCH, b = chain >> 3, h = chain & 7;
        f32x2 S[32];
        if (cc == 0) {
#pragma unroll
            for (int j = 0; j < 32; ++j) S[j] = (f32x2){0.f, 0.f};
        } else { const float* src = PL + (((size_t)chain * NCH + cc - 1) * 2 + 1) * 4096 + lane * 64;
#pragma unroll
            for (int j = 0; j < 16; ++j) { const f32x4 v = *(const f32x4*)(src + 4 * j); S[2 * j] = (f32x2){v[0], v[1]}; S[2 * j + 1] = (f32x2){v[2], v[3]}; } }
        const size_t tb = (size_t)chain * SEQ + (size_t)cc * CHL;
        cfloat* ob = (cfloat*)(scanop + tb * 320); const bf16* vp = vbf + tb * 64 + lane; const float* og = scanop + tb * 320;
        f32x4 pfa = {0.f, 0.f, 0.f, 0.f}; float pfb = 0.f; unsigned short vnext = vp[0];
        for (int t = 0; t < CHL; ++t) { cfloat* o = ob + (size_t)t * 320;
            const unsigned short vcur = vnext; pfdummy += pfa[0] + pfb;
            vnext = vp[(size_t)(t + 1) * 64];
            pfa = *(const f32x4*)(og + (size_t)(t + SCAN_PF) * 320 + lane * 4); pfb = og[(size_t)(t + SCAN_PF) * 320 + 256 + lane];
            const float v = __builtin_bit_cast(float, (unsigned)vcur << 16); const f32x2 vv = {v, v};
            const float sa = SCAN_SA(S, o); const f32x2 sav = {sa, sa}; f32x2 y2 = {0.f, 0.f};
#define P3_BLK(b) { f32x16s w_, a_, k_, r_; SL4(w_, a_, k_, r_, o, 256 + 64 * (b), 512 + 64 * (b), 768 + 64 * (b), 1024 + 64 * (b)); _Pragma("unroll") for (int p_ = 0; p_ < 8; ++p_) { f32x2 s = S[8 * (b) + p_] * PR(w_, p_); s += sav * PR(a_, p_); s += vv * PR(k_, p_); S[8 * (b) + p_] = s; y2 += s * PR(r_, p_); } }
            P3_BLK(0) P3_BLK(1) P3_BLK(2) P3_BLK(3)
#undef P3_BLK
            yl[(t & 15) * 64 + lane] = y2.x + y2.y;
            if ((t & 15) == 15) {
                const int tau = lane >> 2, qd = lane & 3; const int tt = cc * CHL + (t - 15) + tau; const size_t row = (size_t)b * SEQ + tt;
                const float* yb = yl + tau * 64 + 16 * qd; const float* sb = scanop + ((size_t)chain * SEQ + tt) * 320 + 16 * qd;
                float y[16]; float sm = 0.f, bon = 0.f;
#pragma unroll
                for (int q = 0; q < 4; ++q) { const f32x4 yv = *(const f32x4*)(yb + 4 * q); const f32x4 rv = *(const f32x4*)(sb + 256 + 4 * q), kv = *(const f32x4*)(sb + 192 + 4 * q), rk = *(const f32x4*)(r_k + h * 64 + 16 * qd + 4 * q);
#pragma unroll
                    for (int e = 0; e < 4; ++e) { y[4 * q + e] = yv[e]; sm += yv[e]; bon += rv[e] * kv[e] * rk[e]; } }
                sm += __shfl_xor(sm, 1); sm += __shfl_xor(sm, 2); bon += __shfl_xor(bon, 1); bon += __shfl_xor(bon, 2);
                const float mean = sm * (1.f / 64.f); float vs = 0.f;
#pragma unroll
                for (int q = 0; q < 16; ++q) { const float d = y[q] - mean; vs += d * d; }
                vs += __shfl_xor(vs, 1); vs += __shfl_xor(vs, 2);
                const float rstd = rsqrtf(vs * (1.f / 64.f) + 64e-5f);
                const v4u vu0 = *(const v4u*)(vbf + ((size_t)chain * SEQ + tt) * 64 + 16 * qd), vu1 = *(const v4u*)(vbf + ((size_t)chain * SEQ + tt) * 64 + 16 * qd + 8);
                const v4u gu0 = *(const v4u*)(gbuf + row * 512 + h * 64 + 16 * qd), gu1 = *(const v4u*)(gbuf + row * 512 + h * 64 + 16 * qd + 8);
                float out[16];
#pragma unroll
                for (int q = 0; q < 8; ++q) { const unsigned vw = q < 4 ? vu0[q] : vu1[q - 4], gw_ = q < 4 ? gu0[q] : gu1[q - 4]; const int cidx = h * 64 + 16 * qd + 2 * q;
                    out[2 * q] = ((y[2 * q] - mean) * rstd * ln_w[cidx] + ln_b[cidx] + bon * bflo(vw)) * bflo(gw_);
                    out[2 * q + 1] = ((y[2 * q + 1] - mean) * rstd * ln_w[cidx + 1] + ln_b[cidx + 1] + bon * bfhi(vw)) * bfhi(gw_); }
                v4u o0, o1; o0.x = pk2(out[0], out[1]); o0.y = pk2(out[2], out[3]); o0.z = pk2(out[4], out[5]); o0.w = pk2(out[6], out[7]); o1.x = pk2(out[8], out[9]); o1.y = pk2(out[10], out[11]); o1.z = pk2(out[12], out[13]); o1.w = pk2(out[14], out[15]);
                bf16* op = oc + row * 1024 + 512 + h * 64 + 16 * qd; *(v4u*)op = o0; *(v4u*)(op + 8) = o1;
            }
        }
    }
    if (pfdummy == 1.2345e-30f) yl[0] = pfdummy;
}

constexpr int KLD = 104, VLD = 68, KTILE_E = 64 * KLD, VTILE_E = 64 * VLD;
__device__ __forceinline__ void mla_attn_phase(const Ctx&, unsigned char* ws) { const Ctx c = mk_ctx();
    const bf16* q = (const bf16*)(ws + WS_R + R_Q); const bf16* kn = (const bf16*)(ws + WS_R + R_KN); const bf16* krope = (const bf16*)(ws + WS_R + R_KROPE); const bf16* vt = (const bf16*)(ws + WS_R + R_VT); bf16* o = (bf16*)(ws + WS_R + R_O);
    bf16* Kl = (bf16*)c.lds; bf16* Vl = Kl + 2 * KTILE_E;
    const int tid = c.tid, lane = c.lane, wid = c.wid, r = lane & 31, hi = lane >> 5;
    const int kc0_row = tid / 12, kc0_part = tid % 12, kc1_row = (512 + tid) / 12, kc1_part = (512 + tid) % 12, vd = tid >> 3, vpart = tid & 7;
    for (int uu = blockIdx.x; uu < 1024; uu += gridDim.x) {
        const int v0_ = uu & 255, v = (gridDim.x == 256) ? ((v0_ & 7) * 32 + (v0_ >> 3)) : v0_;
        const int ii = uu >> 8, bh = v >> 3, s8 = v & 7, qb = ii == 0 ? s8 : (ii == 1 ? 15 - s8 : (ii == 2 ? 16 + s8 : 31 - s8));
        const int b = bh >> 4, h = bh & 15, Q0 = qb * 256, qw0 = Q0 + 32 * wid; const size_t rowbase = (size_t)b * SEQ;
        bf16x8 qr[6];
#pragma unroll
        for (int s = 0; s < 6; ++s) qr[s] = *(const bf16x8*)(q + (rowbase + qw0 + r) * 1536 + h * 96 + 16 * s + 8 * hi);
        const int ntiles = (Q0 + 256) / 64, my_last = (qw0 + 31) / 64;
        f32x16 oa[2]; oa[0] = f32x16{}; oa[1] = f32x16{}; float mrun = -INFINITY, lrun = 0.f;
        v4u kreg0, kreg1 = {0u, 0u, 0u, 0u}, vreg;
#define MLA_LOAD(j) do { const int t0_ = (j) * 64; \
            kreg0 = kc0_part < 8 ? *(const v4u*)(kn + (rowbase + t0_ + kc0_row) * 1024 + h * 64 + kc0_part * 8) : *(const v4u*)(krope + (rowbase + t0_ + kc0_row) * 32 + (kc0_part - 8) * 8); \
            if (tid < 256) kreg1 = kc1_part < 8 ? *(const v4u*)(kn + (rowbase + t0_ + kc1_row) * 1024 + h * 64 + kc1_part * 8) : *(const v4u*)(krope + (rowbase + t0_ + kc1_row) * 32 + (kc1_part - 8) * 8); \
            vreg = *(const v4u*)(vt + ((size_t)(bh * 64 + vd)) * SEQ + t0_ + vpart * 8); } while (0)
        MLA_LOAD(0);
#pragma unroll 2
        for (int j = 0; j < ntiles; ++j) { bf16* Kb = Kl + (j & 1) * KTILE_E; bf16* Vb = Vl + (j & 1) * VTILE_E;
            *(v4u*)(Kb + kc0_row * KLD + kc0_part * 8) = kreg0; if (tid < 256) *(v4u*)(Kb + kc1_row * KLD + kc1_part * 8) = kreg1;
            *(v2u*)(Vb + vd * VLD + vpart * 8) = (v2u){vreg.x, vreg.y}; *(v2u*)(Vb + vd * VLD + vpart * 8 + 4) = (v2u){vreg.z, vreg.w};
            __syncthreads();
            if (j + 1 < ntiles) MLA_LOAD(j + 1);
            if (j <= my_last) {
                f32x16 p0 = f32x16{}, p1 = f32x16{};
#pragma unroll
                for (int s = 0; s < 6; ++s) { const bf16x8 a0 = *(const bf16x8*)(Kb + r * KLD + 16 * s + 8 * hi), a1 = *(const bf16x8*)(Kb + (r + 32) * KLD + 16 * s + 8 * hi); p0 = MFMA32(a0, qr[s], p0); p1 = MFMA32(a1, qr[s], p1); }
                if (64 * j + 63 > qw0) { const int qq = qw0 + r - 64 * j;
#pragma unroll
                    for (int i = 0; i < 16; ++i) { const int kr_ = crow(i, hi); if (kr_ > qq) p0[i] = -INFINITY; if (kr_ + 32 > qq) p1[i] = -INFINITY; } }
                float mx = fmaxf(p0[0], p1[0]);
#pragma unroll
                for (int i = 1; i < 16; ++i) mx = fmaxf(mx, fmaxf(p0[i], p1[i]));
                mx = fmaxf(mx, __shfl_xor(mx, 32));
                const float mnew = fmaxf(mrun, mx), alpha = __builtin_amdgcn_exp2f(mrun - mnew); const bool grow = !__all(mx <= mrun); mrun = mnew; float ls = 0.f;
#pragma unroll
                for (int i = 0; i < 16; ++i) { p0[i] = __builtin_amdgcn_exp2f(p0[i] - mnew); p1[i] = __builtin_amdgcn_exp2f(p1[i] - mnew); ls += p0[i] + p1[i]; }
                lrun = lrun * alpha + ls;
#pragma unroll
                for (int i = 0; i < 16; ++i) if (grow) { oa[0][i] *= alpha; oa[1][i] *= alpha; }
                bf16x8 pa[4]; pa[0] = pack8(p0, 0); pa[1] = pack8(p0, 1); pa[2] = pack8(p1, 0); pa[3] = pack8(p1, 1);
#pragma unroll
                for (int db = 0; db < 2; ++db)
#pragma unroll
                    for (int ks = 0; ks < 4; ++ks) { const bf16* vp = Vb + (32 * db + r) * VLD + 16 * ks + 4 * hi; oa[db] = MFMA32(cat4(*(const v2u*)vp, *(const v2u*)(vp + 8)), pa[ks], oa[db]); }
            }
        }
#undef MLA_LOAD
        lrun += __shfl_xor(lrun, 32); const float il = 1.0f / lrun;
        bf16* op = o + (rowbase + qw0 + r) * 1024 + h * 64;
#pragma unroll
        for (int db = 0; db < 2; ++db)
#pragma unroll
            for (int g = 0; g < 4; ++g) *(v2u*)(op + 32 * db + 8 * g + 4 * hi) = pk4((f32x4){oa[db][4 * g] * il, oa[db][4 * g + 1] * il, oa[db][4 * g + 2] * il, oa[db][4 * g + 3] * il});
        __syncthreads();
    }
}
#ifndef REP_PHASE
#define REP_PHASE -1
#endif
#define REPLOOP(id) int nrep_ = (REP_PHASE == (id)) ? 2 : 1; asm volatile("" : "+s"(nrep_)); for (int rep_ = 0; rep_ < nrep_; ++rep_)
#ifndef DUP_MLA
#define DUP_MLA 0
#endif
#ifndef DUP_R1
#define DUP_R1 0
#endif
#ifndef DUP_R3
#define DUP_R3 0
#endif
#ifndef DUP_G45
#define DUP_G45 0
#endif
#ifndef DUP_PREP
#define DUP_PREP 0
#endif
#ifndef DUP_SYNC
#define DUP_SYNC 0
#endif
#ifndef STOP_L
#define STOP_L 99
#endif
#ifndef STOP_S
#define STOP_S 99
#endif
#define PH(s) (layer < STOP_L || (layer == STOP_L && (s) <= STOP_S))
#ifndef PH_SB
#define PH_SB 1
#endif
#ifndef PH_PREP
#define PH_PREP 1
#endif
#ifndef PH_S1
#define PH_S1 1
#endif
#ifndef PH_S2
#define PH_S2 1
#endif
#ifndef PH_S3
#define PH_S3 1
#endif
#ifndef PH_MLA
#define PH_MLA 1
#endif
#ifndef PH_GEMM
#define PH_GEMM 1
#endif
#ifndef PH_CONV
#define PH_CONV 1
#endif

#define RLX_AGENT __ATOMIC_RELAXED, __HIP_MEMORY_SCOPE_AGENT
#define XB_TMO      128
#define XB_XCNT(j)  (256  + 64 * (j))
#define XB_XSUB(j)  (1280 + 64 * (j))
#define XB_XGEN(j)  (2304 + 64 * (j))
#define XB_TOP      3328
#define XB_TOPGEN   3392
#define XCD_BAR_WORDS 3456
#define XB_SPIN_CAP (1u << 18)

__device__ __forceinline__ unsigned xb_ld(unsigned* p)              { return __hip_atomic_load(p, __ATOMIC_RELAXED, __HIP_MEMORY_SCOPE_AGENT); }
__device__ __forceinline__ unsigned xb_add(unsigned* p, unsigned v) { return __hip_atomic_fetch_add(p, v, __ATOMIC_RELAXED, __HIP_MEMORY_SCOPE_AGENT); }
__device__ __forceinline__ unsigned xb_xcc_id() { return (unsigned)__builtin_amdgcn_s_getreg((3 << 11) | 20) & 0xFu; }
#define XB_SPIN(cond, bar) do { unsigned _sp = 0; while (cond) { __builtin_amdgcn_s_sleep(1); \
    if ((++_sp & 255u) == 0u) { if (xb_ld(&(bar)[XB_TMO])) break; if (_sp > XB_SPIN_CAP) { atomicAdd(&(bar)[XB_TMO], 1u); break; } } } } while (0)

struct XcdBarrier {
    unsigned* bar; unsigned x;
    volatile LAS unsigned* st;
};

__device__ __forceinline__ XcdBarrier xcd_barrier_post(unsigned* bar, volatile LAS unsigned* st) {
    XcdBarrier b; b.bar = bar; b.x = xb_xcc_id(); b.st = st;
    if (threadIdx.x == 0) (void)xb_add(&bar[XB_XCNT(b.x)], 1u);
    return b;
}
__device__ __forceinline__ void xcd_barrier_complete(unsigned* bar, unsigned x, unsigned& nloc, unsigned& nx) {
    const unsigned G = gridDim.x * gridDim.y * gridDim.z;
    unsigned sum, cnt, mine, sp = 0u;
    for (;;) {
        sum = 0u; cnt = 0u; mine = 0u;
#pragma unroll
        for (unsigned j = 0; j < 16; ++j) { const unsigned c = xb_ld(&bar[XB_XCNT(j)]); sum += c; cnt += (c > 0u) ? 1u : 0u; mine = (j == x) ? c : mine; }
        if (sum == G) break;
        __builtin_amdgcn_s_sleep(1);
        if ((++sp & 255u) == 0u) { if (xb_ld(&bar[XB_TMO])) break; if (sp > XB_SPIN_CAP) { atomicAdd(&bar[XB_TMO], 1u); break; } }
    }
    nloc = mine > 0u ? mine : 1u; nx = cnt > 0u ? cnt : 1u;
}

__device__ __forceinline__ void xcd_barrier(const XcdBarrier& b) {
    asm volatile("s_waitcnt vmcnt(0)" ::: "memory");
    __syncthreads();
    if (threadIdx.x == 0) {
        unsigned* bar = b.bar;
        __builtin_amdgcn_s_waitcnt(0);
        unsigned nloc = b.st[0], nx = b.st[1];
        if (nloc == 0u) { xcd_barrier_complete(bar, b.x, nloc, nx); b.st[0] = nloc; b.st[1] = nx; }
        const unsigned old = xb_add(&bar[XB_XSUB(b.x)], 1u);
        const unsigned gen = old / nloc;
        if (old + 1u == (gen + 1u) * nloc) {
            __builtin_amdgcn_fence(__ATOMIC_RELEASE, "agent");
            asm volatile("s_waitcnt vmcnt(0)" ::: "memory");
            const unsigned og = xb_add(&bar[XB_TOP], 1u);
            const unsigned tg = og / nx;
            if (og + 1u == (tg + 1u) * nx) xb_add(&bar[XB_TOPGEN], 1u);
            else XB_SPIN(xb_ld(&bar[XB_TOPGEN]) == tg, bar);
            __builtin_amdgcn_fence(__ATOMIC_ACQUIRE, "agent");
            xb_add(&bar[XB_XGEN(b.x)], 1u);
            asm volatile("s_waitcnt vmcnt(0)" ::: "memory");
        } else {
            XB_SPIN(xb_ld(&bar[XB_XGEN(b.x)]) == gen, bar);
            __builtin_amdgcn_fence(__ATOMIC_ACQUIRE, "agent");
            asm volatile("s_waitcnt vmcnt(0)" ::: "memory");
        }
    }
    __syncthreads();
}

constexpr int LDS_BYTES = 131072 + 512;
struct Args { const float* in[33]; float* out; unsigned char* ws; };

__global__ void __launch_bounds__(512, 2) mega_fwd(Args a) {
    unsigned char* lds = g_lds;
    Ctx c{};
    LAS unsigned char* ldsl = (LAS unsigned char*)lds;
    In in;
    if (threadIdx.x < 33) ((unsigned long long*)(lds + 131072))[threadIdx.x] = (unsigned long long)a.in[threadIdx.x];
    if (threadIdx.x == 33) ((unsigned long long*)(lds + 131072))[33] = (unsigned long long)a.out;
    if (threadIdx.x == 34) ((unsigned long long*)(lds + 131072))[34] = (unsigned long long)a.ws;
    if (threadIdx.x == 35) { ((unsigned*)(lds + 131072 + 384))[0] = 0u; ((unsigned*)(lds + 131072 + 384))[1] = 0u; }
    if (threadIdx.x == 0) (void)xb_add(&((unsigned*)a.ws)[XB_XCNT(xb_xcc_id())], 1u);
    __syncthreads();
#define h ((float*)in[33])
#define ws ((unsigned char*)in[34])
#define rss ((float*)(ws + WS_RSS))
#define tab ((const float*)(ws + WS_ROPE))
#define hA ((bf16*)(ws + WS_HA))
#define hA2 ((bf16*)(ws + WS_R + R_HA2))
#define W (ws + WS_W)
#define R (ws + WS_R)
#define SYNC() do { asm volatile("s_waitcnt vmcnt(0) lgkmcnt(0)" ::: "memory"); XcdBarrier xb_; xb_.bar = (unsigned*)P_WS; xb_.x = xb_xcc_id(); xb_.st = (volatile LAS unsigned*)(LAS unsigned char*)(g_lds + PTAB_OFF + 384); xcd_barrier(xb_); } while (0)

    phase0(c, in, h, ws);
#if PH_CONV
    conv_mixer(c, in, ws, 0); conv_ffn(c, in, ws, 0); conv_p(c, in, ws, 0);
#endif
    SYNC();

    for (int layer = 0; layer < 4; ++layer) {
        const int jl = layer >> 1;
        if ((layer & 1) == 0) {
{ REPLOOP(0) {             if (PH(0)) { { EpiHybIn e{layer}; run_gemm<0>(ldsl, hA2, (const bf16*)(W + W_HYBIN), T, 3584, 1024, e); } } if (rep_ + 1 < nrep_) SYNC(); } }
            if (layer > 0) conv_ffn(c, in, ws, layer);
            SYNC();
#if PH_PREP
{ REPLOOP(6) {             if (PH(1)) { rw_prep_phase(c, in, ws, jl); } if (rep_ + 1 < nrep_) SYNC(); } }
#if DUP_PREP
            SYNC(); rw_prep_phase(c, in, ws, jl);
#endif
#endif
            SYNC();
            if (PH(2)) { { EpiLora e{layer}; run_gemm<1>(ldsl, (const bf16*)(ws + WS_HA + HA_ACAT), (const bf16*)(W + W_LORA), T, 1536, 384, e); } }
            SYNC();
#if PH_S1
{ REPLOOP(1) {             if (PH(3)) { if (__builtin_amdgcn_readfirstlane(threadIdx.x >> 6) < 4) scan_pass1(c, ws, jl); else sb_attn_phase(c, (bf16*)(R + R_QK), (const bf16*)(R + R_VTSB)); } if (rep_ + 1 < nrep_) SYNC(); } }
#if DUP_R1
            SYNC(); scan_pass1(c, ws, jl);
#endif
#endif
            SYNC();
#if PH_S2
            if (PH(4)) { scan_pass2(c, ws); }
#endif
            SYNC();
#if PH_S3
{ REPLOOP(2) {             if (PH(5)) { scan_pass3(c, in, ws, jl, jl); } if (rep_ + 1 < nrep_) SYNC(); } }
#if DUP_R3
            SYNC(); scan_pass3(c, in, ws, jl, jl);
#endif
#endif
            SYNC();
            if (PH(6)) { { EpiResid e{layer, 0}; run_gemm<2>(ldsl, (const bf16*)(R + R_QK), (const bf16*)(W + W_HYBOUT), T, 1024, 1024, e); } }
            SYNC();
        } else {
            if (PH(0)) { EpiMlaDown e{layer};
              run_gemm<3>(ldsl, hA2, (const bf16*)(W + W_DOWN), T, 768, 1024, e); }
            conv_ffn(c, in, ws, layer);
            SYNC();
            if (PH(1)) { { EpiUq e{layer}; run_gemm<4>(ldsl, (const bf16*)(R + R_CQ), (const bf16*)(W + W_UQ), T, 1536, 384, e); } }
            if (PH(1)) { { EpiUkv e{layer}; run_gemm<5>(ldsl, (const bf16*)(R + R_CKV), (const bf16*)(W + W_UKV), T, 2048, 256, e); } }
            SYNC();
#if PH_MLA
{ REPLOOP(3) {             if (PH(2)) { mla_attn_phase(c, ws); } if (rep_ + 1 < nrep_) SYNC(); } }
#if DUP_MLA
            SYNC(); mla_attn_phase(c, ws);
#endif
#endif
            SYNC();
            if (PH(6)) { { EpiResid e{layer, 0}; run_gemm<6>(ldsl, (const bf16*)(R + R_O), (const bf16*)(W + W_WO), T, 1024, 1024, e); } }
            SYNC();
        }
{ REPLOOP(4) {         if (PH(7)) { { EpiFfnG e{layer}; run_gemm<7>(ldsl, hA, (const bf16*)(W + W_FFNIN) + (size_t)FFN * 1024, T, FFN, 1024, e); } } if (rep_ + 1 < nrep_) SYNC(); } }
{ REPLOOP(7) {         if (PH(7)) { { EpiPe e{layer}; run_gemm<8>(ldsl, (const bf16*)(ws + WS_PB), (const bf16*)(W + W_PLEP), T, 1024, 256, e); } } if (rep_ + 1 < nrep_) SYNC(); } }
#if PH_CONV
        if (PH(7)) { if (layer < 3) conv_mixer(c, in, ws, layer + 1); }
#endif
        SYNC();
{ REPLOOP(5) {         if (PH(8)) { { EpiFfnU e{layer}; run_gemm<9>(ldsl, hA, (const bf16*)(W + W_FFNIN), T, FFN, 1024, e); } } if (rep_ + 1 < nrep_) SYNC(); } }
#if DUP_G45
        SYNC(); { EpiFfnG e{layer}; run_gemm<7>(ldsl, hA, (const bf16*)(W + W_FFNIN) + (size_t)FFN * 1024, T, FFN, 1024, e); }
        SYNC(); { EpiFfnU e{layer}; run_gemm<9>(ldsl, hA, (const bf16*)(W + W_FFNIN), T, FFN, 1024, e); }
#endif
#if DUP_SYNC
        SYNC(); SYNC(); SYNC(); SYNC(); SYNC(); SYNC(); SYNC(); SYNC(); SYNC(); SYNC();
#endif
        SYNC();
        if (PH(9)) { { EpiResid e{layer, 1}; run_gemm<10>(ldsl, (const bf16*)(R + R_ACT), (const bf16*)(W + W_FFNOUT), T, 1024, FFN, e); } }
#if PH_CONV
        if (PH(9)) { if (layer < 3) conv_p(c, in, ws, layer + 1); }
#endif
        SYNC();
        if (PH(10)) { EpiPleGate e{layer};
          run_gemm<11>(ldsl, hA, (const bf16*)(W + W_PLEG), T, 1024, 1024, e); }
        SYNC();
    }
    phase_final(c, in, h, ws);
    if (gridDim.x == 0x7fffffffu) cg::this_grid().sync();
#undef SYNC
#undef h
#undef ws
#undef rss
#undef tab
#undef hA
#undef hA2
#undef W
#undef R
}

extern "C" void kernel_launch(void* const* d_in, const int* in_sizes, int n_in, void* d_out, int out_size, void* d_ws, size_t ws_size, hipStream_t stream) {
    static int grid_blocks = 0;
    if (grid_blocks == 0) {
        if (n_in != 33 || out_size != T * D || ws_size < WS_NEED) { fprintf(stderr, "kernel_launch: unexpected problem (n_in %d out %d ws %zu)\n", n_in, out_size, ws_size); grid_blocks = -1; return; }
        int dev = 0, cus = 0, per_cu = 0;
        hipGetDevice(&dev); hipDeviceGetAttribute(&cus, hipDeviceAttributeMultiprocessorCount, dev);
        hipFuncSetAttribute((const void*)mega_fwd, hipFuncAttributeMaxDynamicSharedMemorySize, LDS_BYTES);
        hipOccupancyMaxActiveBlocksPerMultiprocessor(&per_cu, (const void*)mega_fwd, 512, LDS_BYTES);
        if (per_cu < 1) per_cu = 1;
        (void)hipGetLastError();
        grid_blocks = cus * per_cu;
    }
    if (grid_blocks < 0) return;
    if (hipMemsetAsync(d_ws, 0, 16384, stream) != hipSuccess) { fprintf(stderr, "memset failed\n"); return; }
    Args a{};
    for (int i = 0; i < 33; ++i) a.in[i] = (const float*)d_in[i];
    a.out = (float*)d_out; a.ws = (unsigned char*)d_ws;
    void* args[] = {&a};
    hipError_t e = hipLaunchCooperativeKernel((const void*)mega_fwd, dim3(grid_blocks), dim3(512), args, LDS_BYTES, stream);
    if (e != hipSuccess) fprintf(stderr, "cooperative launch failed: %s (grid %d)\n", hipGetErrorString(e), grid_blocks);
}
```
